# Optimizing an MI355X kernel written in HIP

```python
import math
import jax
import jax.numpy as jnp
from jax import lax
import numpy as np

D_MODEL = 1024
BATCH = 16
SEQ = 2048
DEPTH = 1

SGU_GROUPS = 8
SGU_GROUP_DIM = 128
SGU_WIDTH = SGU_GROUPS * SGU_GROUP_DIM
SGU_CHUNK = 128
DIFF_HEADS = 8
DIFF_HEAD_DIM = 64
DIFF_V_DIM = 2 * DIFF_HEAD_DIM
DIFF_WIDTH = DIFF_HEADS * DIFF_V_DIM
DIFF_QK_WIDTH = DIFF_HEADS * 2 * DIFF_HEAD_DIM
Q_BLOCK = 128
MEM_LEN = 256
MEM_HEADS = 4
MEM_HEAD_DIM = 256
MEM_WIDTH = MEM_HEADS * MEM_HEAD_DIM
N_BRANCHES = 3
BRANCH_WIDTH = 1024
IN_WIDTH = 2 * SGU_WIDTH + 2 * DIFF_QK_WIDTH + DIFF_WIDTH + MEM_WIDTH
IN_SPLITS = (2 * SGU_WIDTH,
             2 * SGU_WIDTH + DIFF_QK_WIDTH,
             2 * SGU_WIDTH + 2 * DIFF_QK_WIDTH,
             2 * SGU_WIDTH + 2 * DIFF_QK_WIDTH + DIFF_WIDTH)
NUM_BUCKETS = 32
MAX_EXACT = 16
MAX_DISTANCE = 128
PEER_HEADS = 8
N_KEYS = 128
N_EXPERTS = N_KEYS * N_KEYS
PEER_TOPK = 16
PEER_QDIM = 256
PEER_CHUNK = 128
ALPHA = (2.0 * DEPTH) ** 0.25
BETA = (8.0 * DEPTH) ** -0.25
LN_EPS = 1e-5
NEG_INF = -1e30

kernel_name = "hybrid_sgu_diffattn_memxattn_peer"


def layer_norm(x, g, b):
    xf = x.astype(jnp.float32)
    mu = jnp.mean(xf, axis=-1, keepdims=True)
    var = jnp.mean(jnp.square(xf - mu), axis=-1, keepdims=True)
    return ((xf - mu) * lax.rsqrt(var + LN_EPS)).astype(x.dtype) * g + b


def rms_norm(x, g):
    xf = x.astype(jnp.float32)
    return (xf * lax.rsqrt(jnp.mean(jnp.square(xf), axis=-1, keepdims=True) + LN_EPS)).astype(x.dtype) * g


def t5_bucket(rel):
    n = jnp.maximum(rel, 0)
    nf = jnp.maximum(n, 1).astype(jnp.float32)
    large = MAX_EXACT + (jnp.log(nf / MAX_EXACT) / math.log(MAX_DISTANCE / MAX_EXACT)
                         * (NUM_BUCKETS - MAX_EXACT)).astype(jnp.int32)
    large = jnp.minimum(large, NUM_BUCKETS - 1)
    return jnp.where(n < MAX_EXACT, n, large)


def spatial_gating(z, ln_g, ln_b, w_spatial, b_spatial):
    B, S, _ = z.shape
    z = jax.nn.gelu(z, approximate=False)
    u, v = jnp.split(z, 2, axis=-1)
    v = layer_norm(v, ln_g, ln_b)
    vc = v.reshape(B, S // SGU_CHUNK, SGU_CHUNK, SGU_GROUPS, SGU_GROUP_DIM)
    causal = jnp.tril(jnp.ones((SGU_CHUNK, SGU_CHUNK), dtype=w_spatial.dtype))
    w = w_spatial * causal
    s = jnp.einsum('gts,bcsgd->bctgd', w, vc) + b_spatial.T[:, :, None]
    return u * s.reshape(B, S, SGU_WIDTH)


def diff_attention(q1, q2, k1, k2, v, rel_bias_table, lam, lam_init, subln_g):
    B, S, H, DH = q1.shape
    scale = DH ** -0.5
    k_pos = jnp.arange(S)

    def block(i):
        start = i * Q_BLOCK
        qb1 = lax.dynamic_slice_in_dim(q1, start, Q_BLOCK, axis=1)
        qb2 = lax.dynamic_slice_in_dim(q2, start, Q_BLOCK, axis=1)
        q_pos = start + jnp.arange(Q_BLOCK)
        rel = q_pos[:, None] - k_pos[None, :]
        bias = jnp.transpose(rel_bias_table[t5_bucket(rel)], (2, 0, 1)).astype(jnp.float32)
        causal = rel >= 0

        def probs(qb, k):
            s = jnp.einsum('bqhd,bkhd->bhqk', qb, k).astype(jnp.float32) * scale + bias
            s = jnp.where(causal, s, NEG_INF)
            return jax.nn.softmax(s, axis=-1)

        a = probs(qb1, k1) - lam * probs(qb2, k2)
        return jnp.einsum('bhqk,bkhd->bqhd', a.astype(v.dtype), v)

    out = lax.map(block, jnp.arange(S // Q_BLOCK))
    out = jnp.transpose(out, (1, 0, 2, 3, 4)).reshape(B, S, H, 2 * DH)
    out = rms_norm(out, subln_g) * (1.0 - lam_init)
    return out.reshape(B, S, H * 2 * DH)


def memory_attention(q_m, mem, w_mem_kv):
    B, S, _ = q_m.shape
    M = mem.shape[1]
    q = q_m.reshape(B, S, MEM_HEADS, MEM_HEAD_DIM)
    kv = (mem @ w_mem_kv).reshape(B, M, 2, MEM_HEADS, MEM_HEAD_DIM)
    k, v = kv[:, :, 0], kv[:, :, 1]
    s = jnp.einsum('bshd,bmhd->bhsm', q, k).astype(jnp.float32) * (MEM_HEAD_DIM ** -0.5)
    p = jax.nn.softmax(s, axis=-1).astype(v.dtype)
    return jnp.einsum('bhsm,bmhd->bshd', p, v).reshape(B, S, MEM_WIDTH)


def mixing_sublayer(x, mem, w_in, sgu_ln_g, sgu_ln_b, w_spatial, b_spatial,
                    lq1, lk1, lq2, lk2, subln_g, rel_bias_table, w_mem_kv,
                    w_gate, b_gate, w_branch, w_out, lam_init):
    B, S, _ = x.shape
    proj = x @ w_in
    z_sgu, q_d, k_d, v_d, q_m = jnp.split(proj, IN_SPLITS, axis=-1)
    h_a = spatial_gating(z_sgu, sgu_ln_g, sgu_ln_b, w_spatial, b_spatial)
    q_d = q_d.reshape(B, S, DIFF_HEADS, 2, DIFF_HEAD_DIM)
    k_d = k_d.reshape(B, S, DIFF_HEADS, 2, DIFF_HEAD_DIM)
    v_d = v_d.reshape(B, S, DIFF_HEADS, DIFF_V_DIM)
    lam = (jnp.exp(jnp.sum(lq1.astype(jnp.float32) * lk1.astype(jnp.float32)))
           - jnp.exp(jnp.sum(lq2.astype(jnp.float32) * lk2.astype(jnp.float32))) + lam_init)
    h_b = diff_attention(q_d[:, :, :, 0], q_d[:, :, :, 1], k_d[:, :, :, 0], k_d[:, :, :, 1],
                         v_d, rel_bias_table, lam, lam_init, subln_g)
    h_c = memory_attention(q_m, mem, w_mem_kv)
    h = jnp.stack([h_a, h_b, h_c], axis=2)
    branch = jnp.einsum('bsnc,ncd->bsnd', h, w_branch)
    gates = jax.nn.sigmoid(x @ w_gate + b_gate).reshape(B, S, N_BRANCHES, D_MODEL)
    merged = jnp.sum(gates * branch, axis=2)
    return merged @ w_out


def peer_ffn(x, w_q, sub_keys, expert_u, expert_v):
    B, S, D = x.shape
    half = PEER_QDIM // 2
    q = jnp.einsum('bsd,dhq->bshq', x, w_q)
    s1 = jnp.einsum('bshk,hnk->bshn', q[..., :half], sub_keys[:, 0])
    s2 = jnp.einsum('bshk,hnk->bshn', q[..., half:], sub_keys[:, 1])
    v1, i1 = lax.top_k(s1, PEER_TOPK)
    v2, i2 = lax.top_k(s2, PEER_TOPK)
    n_cand = PEER_TOPK * PEER_TOPK
    cand_s = (v1[..., :, None] + v2[..., None, :]).reshape(B, S, PEER_HEADS, n_cand)
    cand_i = (i1[..., :, None] * N_KEYS + i2[..., None, :]).reshape(B, S, PEER_HEADS, n_cand)
    top_s, pos = lax.top_k(cand_s, PEER_TOPK)
    idx = jnp.take_along_axis(cand_i, pos, axis=-1)
    g = jax.nn.softmax(top_s.astype(jnp.float32), axis=-1).astype(x.dtype)
    n_chunks = (B * S) // PEER_CHUNK
    E = PEER_HEADS * PEER_TOPK
    xc = x.reshape(n_chunks, PEER_CHUNK, D)
    ic = idx.reshape(n_chunks, PEER_CHUNK, E)
    gc = g.reshape(n_chunks, PEER_CHUNK, E)

    def chunk(args):
        xb, ib, gb = args
        u = jnp.take(expert_u, ib, axis=0)
        act = jax.nn.gelu(jnp.einsum('cd,ced->ce', xb, u), approximate=False)
        v = jnp.take(expert_v, ib, axis=0)
        return jnp.einsum('ce,ced->cd', gb * act, v)

    out = lax.map(chunk, (xc, ic, gc))
    return out.reshape(B, S, D)


def setup_inputs(seed: int = 0) -> dict:
    key = jax.random.key(seed)
    ks = jax.random.split(key, 26)

    def nrm(k, shape, scale):
        return jax.random.normal(k, shape, jnp.float32) * scale

    L = DEPTH
    D = D_MODEL
    return {
        "x": nrm(ks[0], (BATCH, SEQ, D), 1.0),
        "mem": nrm(ks[1], (BATCH, MEM_LEN, D), 1.0),
        "w_in": nrm(ks[2], (L, D, IN_WIDTH), D ** -0.5),
        "sgu_ln_g": 1.0 + nrm(ks[3], (L, SGU_WIDTH), 0.02),
        "sgu_ln_b": nrm(ks[4], (L, SGU_WIDTH), 0.02),
        "w_spatial": nrm(ks[5], (L, SGU_GROUPS, SGU_CHUNK, SGU_CHUNK), SGU_CHUNK ** -0.5),
        "b_spatial": 1.0 + nrm(ks[6], (L, SGU_GROUPS, SGU_CHUNK), 0.02),
        "diff_lambda_q1": nrm(ks[7], (L, DIFF_HEAD_DIM), 0.1),
        "diff_lambda_k1": nrm(ks[8], (L, DIFF_HEAD_DIM), 0.1),
        "diff_lambda_q2": nrm(ks[9], (L, DIFF_HEAD_DIM), 0.1),
        "diff_lambda_k2": nrm(ks[10], (L, DIFF_HEAD_DIM), 0.1),
        "diff_subln_g": 1.0 + nrm(ks[11], (L, DIFF_V_DIM), 0.02),
        "rel_bias_table": nrm(ks[12], (NUM_BUCKETS, DIFF_HEADS), 0.5),
        "w_mem_kv": nrm(ks[13], (L, D, 2 * MEM_WIDTH), D ** -0.5),
        "w_gate": nrm(ks[14], (L, D, N_BRANCHES * D), D ** -0.5),
        "b_gate": nrm(ks[15], (L, N_BRANCHES * D), 0.02),
        "w_branch": nrm(ks[16], (L, N_BRANCHES, BRANCH_WIDTH, D), BETA * BRANCH_WIDTH ** -0.5),
        "w_out": nrm(ks[17], (L, D, D), BETA * D ** -0.5),
        "ln1_g": 1.0 + nrm(ks[18], (L, D), 0.02),
        "ln1_b": nrm(ks[19], (L, D), 0.02),
        "w_peer_q": nrm(ks[20], (L, D, PEER_HEADS, PEER_QDIM), D ** -0.5),
        "peer_sub_keys": nrm(ks[21], (L, PEER_HEADS, 2, N_KEYS, PEER_QDIM // 2), (PEER_QDIM // 2) ** -0.5),
        "peer_u": nrm(ks[22], (L, N_EXPERTS, D), D ** -0.5),
        "peer_v": nrm(ks[23], (L, N_EXPERTS, D), BETA),
        "ln2_g": 1.0 + nrm(ks[24], (L, D), 0.02),
        "ln2_b": nrm(ks[25], (L, D), 0.02),
    }


def reference(x, mem, w_in, sgu_ln_g, sgu_ln_b, w_spatial, b_spatial,
              diff_lambda_q1, diff_lambda_k1, diff_lambda_q2, diff_lambda_k2, diff_subln_g,
              rel_bias_table, w_mem_kv, w_gate, b_gate, w_branch, w_out, ln1_g, ln1_b,
              w_peer_q, peer_sub_keys, peer_u, peer_v, ln2_g, ln2_b):
    for l in range(DEPTH):
        lam_init = 0.8 - 0.6 * math.exp(-0.3 * l)
        y = mixing_sublayer(x, mem, w_in[l], sgu_ln_g[l], sgu_ln_b[l], w_spatial[l], b_spatial[l],
                            diff_lambda_q1[l], diff_lambda_k1[l], diff_lambda_q2[l], diff_lambda_k2[l],
                            diff_subln_g[l], rel_bias_table, w_mem_kv[l], w_gate[l], b_gate[l],
                            w_branch[l], w_out[l], lam_init)
        x = layer_norm(ALPHA * x + y, ln1_g[l], ln1_b[l])
        y = peer_ffn(x, w_peer_q[l], peer_sub_keys[l], peer_u[l], peer_v[l])
        x = layer_norm(ALPHA * x + y, ln2_g[l], ln2_b[l])
    return x
```

```cpp
#include <hip/hip_runtime.h>
#include <cstdio>
#include <cstdint>
#include <cmath>

#ifndef SC_A
#define SC_A 1.f
#endif
#ifndef SC_B
#define SC_B 1.f
#endif
#ifndef SC_C
#define SC_C 1.f
#endif
#ifndef ABL_BR
#define ABL_BR 0
#endif
#ifndef ABL_PEER
#define ABL_PEER 0
#endif
#ifndef ABL_Y
#define ABL_Y 0
#endif
#ifdef DBG
#define MK_N_LAUNCHES 10
#ifndef DBG_PAIR
#define DBG_PAIR 0
#endif
#endif
#ifndef MK_N_LAUNCHES
#define MK_N_LAUNCHES 1
#endif

namespace pg8 {
#define PG8_LAS __attribute__((address_space(3)))
typedef unsigned short bf16_t;
typedef short bf16x8 __attribute__((ext_vector_type(8)));
typedef float f32x4 __attribute__((ext_vector_type(4)));
typedef unsigned u32x4 __attribute__((ext_vector_type(4)));
typedef unsigned u32x2 __attribute__((ext_vector_type(2)));
constexpr int BM = 256, BK = 64, HALF = 128, HTB = HALF * BK * 2  , STAGE_BYTES = 8 * HTB, NXCD = 8, WGM = 8;

__host__ __device__ __forceinline__ int lds_byte(int r, int c) { const int st = (r >> 4) * 2 + (c >> 5), rr = r & 15, cc = c & 31, ob = rr * 64 + cc * 2; return st * 1024 + (ob ^ (((ob >> 9) & 1) << 5)); }
__host__ __device__ __forceinline__ void stage_rc(int b, int& R, int& C) { const int st = b / 1024, sb = b % 1024, swz = sb ^ (((sb >> 9) & 1) << 5); R = (st >> 1) * 16 + swz / 64; C = (st & 1) * 32 + (swz % 64) / 2; }
__host__ __device__ __forceinline__ int perm32(int rho) { const int n = rho >> 4, i = rho & 15; return 8 * (i >> 2) + 4 * n + (i & 3); }

struct Unit { int pm, pn, job; };
struct Gemm { const bf16_t *A0, *A1, *A2, *A3; const bf16_t *B0, *B1, *B2, *B3; int K; };
__device__ __forceinline__ const char* jobA(const Gemm& g, int j) { return (const char*)(j == 0 ? g.A0 : j == 1 ? g.A1 : j == 2 ? g.A2 : g.A3); }
__device__ __forceinline__ const char* jobB(const Gemm& g, int j) { return (const char*)(j == 0 ? g.B0 : j == 1 ? g.B1 : j == 2 ? g.B2 : g.B3); }

struct MultiOrder {
    int nM0, nN0, nM1, nN1, nM2, nN2, nM3, nN3, s1, s2, s3, s4, G, c;
    __device__ void init(int G_, int c_, int m0, int n0, int m1 = 0, int n1 = 0, int m2 = 0, int n2 = 0, int m3 = 0, int n3 = 0) {
        nM0 = m0; nN0 = n0; nM1 = m1; nN1 = n1; nM2 = m2; nN2 = n2; nM3 = m3; nN3 = n3; s1 = m0 * n0; s2 = s1 + m1 * n1; s3 = s2 + m2 * n2; s4 = s3 + m3 * n3; G = G_; c = c_; }
    __device__ bool next(int i, Unit& u) const {
        const long L = (long)i * G + c; if (L >= s4) return false;
        int nM, nN, loc;
        if (L < s1) { u.job = 0; nM = nM0; nN = nN0; loc = (int)L; }
        else if (L < s2) { u.job = 1; nM = nM1; nN = nN1; loc = (int)L - s1; }
        else if (L < s3) { u.job = 2; nM = nM2; nN = nN2; loc = (int)L - s2; }
        else { u.job = 3; nM = nM3; nN = nN3; loc = (int)L - s3; }
        const int nwg = nM * nN; int wgid = loc; { const int q = nwg / NXCD, r = nwg % NXCD, xcd = wgid % NXCD, off = wgid / NXCD; wgid = (xcd < r ? xcd * (q + 1) : r * (q + 1) + (xcd - r) * q) + off; }
        const int nig = WGM * nN, gid = wgid / nig, fm = gid * WGM, gsz = (nM - fm) < WGM ? (nM - fm) : WGM;
        u.pm = fm + ((wgid % nig) % gsz); u.pn = (wgid % nig) / gsz; return true;
    }
    __device__ __forceinline__ void a_ready(const Unit&) const {}
    __device__ __forceinline__ void done(const Unit&) const {}
};

typedef float f32x2 __attribute__((ext_vector_type(2)));
typedef __bf16 bf16x2v __attribute__((ext_vector_type(2)));
__device__ __forceinline__ unsigned cvt_pk_bf16(float lo, float hi) { f32x2 v = {lo, hi}; bf16x2v b = __builtin_convertvector(v, bf16x2v); return __builtin_bit_cast(unsigned, b); }
__device__ __forceinline__ f32x2 gelu_pk(f32x2 v) {
    const f32x2 av = __builtin_elementwise_abs(v), d = av * 0.2316418882f + 1.0f;
    f32x2 t; t.x = __builtin_amdgcn_rcpf(d.x); t.y = __builtin_amdgcn_rcpf(d.y);
    f32x2 q = t * 0.5307027145f + (-0.7265760135f); q = q * t + 0.7107068705f; q = q * t + (-0.142248368f); q = q * t + 0.127414796f; q = q * t;
    const f32x2 s = (v * v) * (-0.72134752044f);
    f32x2 e; e.x = __builtin_amdgcn_exp2f(s.x); e.y = __builtin_amdgcn_exp2f(s.y);
    const f32x2 m = v * (q * e), r = v - m;
    f32x2 o; o.x = v.x < 0.f ? m.x : r.x; o.y = v.y < 0.f ? m.y : r.y; return o;
}
__device__ __forceinline__ float bf_lo(unsigned w) { return __uint_as_float(w << 16); }
__device__ __forceinline__ float bf_hi(unsigned w) { return __uint_as_float(w & 0xffff0000u); }
__device__ __forceinline__ float sigmoidf_(float x) { return __builtin_amdgcn_rcpf(1.0f + __builtin_amdgcn_exp2f(-1.4426950408889634f * x)); }

template <int MODE>
__device__ __forceinline__ void store_tile_bf16(const f32x4 (&acc)[2][2][4][2], bf16_t* base, int ldc, int row0, int col0, float sc, const float* bias, const bf16_t* gate) {
    f32x4 bv[2][2];
    if (MODE == 3) {
#pragma unroll
        for (int bj = 0; bj < 2; ++bj)
#pragma unroll
            for (int n = 0; n < 2; ++n) bv[bj][n] = *(const f32x4*)(bias + bj * HALF + 4 * n);
    }
#pragma unroll
    for (int ai = 0; ai < 2; ++ai)
#pragma unroll
        for (int m = 0; m < 4; ++m) { const size_t roff = (size_t)(row0 + ai * HALF + m * 16) * ldc + col0;
#pragma unroll
            for (int bj = 0; bj < 2; ++bj) { f32x4 v0 = acc[ai][bj][m][0], v1 = acc[ai][bj][m][1];
                if (MODE == 1) { f32x2 a = gelu_pk((f32x2){v0[0], v0[1]}), b = gelu_pk((f32x2){v0[2], v0[3]}), c = gelu_pk((f32x2){v1[0], v1[1]}), d = gelu_pk((f32x2){v1[2], v1[3]});
                    v0 = (f32x4){a.x, a.y, b.x, b.y}; v1 = (f32x4){c.x, c.y, d.x, d.y}; }
                if (MODE == 2) { v0 = v0 * sc; v1 = v1 * sc; }
#ifdef ABL_SNOISE
                if (MODE == 0 && sc == 2.f) { const unsigned hsh = (unsigned)(roff + bj * HALF) * 2654435761u;
#pragma unroll
                    for (int q = 0; q < 4; ++q) { const unsigned h0 = (hsh + q * 0x9E3779B9u) * 1664525u + 1013904223u, h1 = h0 * 1664525u + 1013904223u;
                        v0[q] += ((float)(h0 >> 16) * (1.f / 65536.f) - 0.5f) * 0.07f; v1[q] += ((float)(h1 >> 16) * (1.f / 65536.f) - 0.5f) * 0.07f; } }
#endif
                if (MODE == 3) { v0 = v0 + bv[bj][0]; v1 = v1 + bv[bj][1];
                    v0 = (f32x4){sigmoidf_(v0[0]), sigmoidf_(v0[1]), sigmoidf_(v0[2]), sigmoidf_(v0[3])}; v1 = (f32x4){sigmoidf_(v1[0]), sigmoidf_(v1[1]), sigmoidf_(v1[2]), sigmoidf_(v1[3])}; }
                if (MODE == 4 || MODE == 5) { const u32x4 g = *(const u32x4*)(gate + roff + bj * HALF); v0 = v0 * sc; v1 = v1 * sc;
                    v0 = v0 * (f32x4){bf_lo(g.x), bf_hi(g.x), bf_lo(g.y), bf_hi(g.y)}; v1 = v1 * (f32x4){bf_lo(g.z), bf_hi(g.z), bf_lo(g.w), bf_hi(g.w)};
                    if (MODE == 5) { const u32x4 t = __builtin_nontemporal_load((const u32x4*)(base + roff + bj * HALF));
                        v0 = v0 + (f32x4){bf_lo(t.x), bf_hi(t.x), bf_lo(t.y), bf_hi(t.y)}; v1 = v1 + (f32x4){bf_lo(t.z), bf_hi(t.z), bf_lo(t.w), bf_hi(t.w)}; } }
                u32x4 w; w.x = cvt_pk_bf16(v0[0], v0[1]); w.y = cvt_pk_bf16(v0[2], v0[3]); w.z = cvt_pk_bf16(v1[0], v1[1]); w.w = cvt_pk_bf16(v1[2], v1[3]);
                *(u32x4*)(base + roff + bj * HALF) = w; } }
}

constexpr float C_DIFF = 0.125f * 1.4426950408889634f;
constexpr float C_MEMQ = 0.0625f * 1.4426950408889634f;

struct EpiP1 {
    static constexpr bool PERM = true, AFTER_DRAIN = false;
    bf16_t *U, *V, *QD, *KD, *QM, *VDT, *KM, *VMT;
    __device__ __forceinline__ void operator()(const f32x4 (&acc)[2][2][4][2], const Unit& u, int wr, int wc, int fr, int fq) const {
        const int row0 = u.pm * BM + wr * 64 + fr, cin = wc * 32 + 8 * fq;
        if (u.job == 0) { const int t = u.pn >> 2, col0 = (u.pn & 3) * BM + cin;
            if (t == 0) store_tile_bf16<1>(acc, U, 1024, row0, col0, 1.f, nullptr, nullptr);
            else if (t == 1) store_tile_bf16<1>(acc, V, 1024, row0, col0, 1.f, nullptr, nullptr);
            else if (t == 2) store_tile_bf16<2>(acc, QD, 1024, row0, col0, C_DIFF, nullptr, nullptr);
            else if (t == 3) store_tile_bf16<0>(acc, KD, 1024, row0, col0, 1.f, nullptr, nullptr);
            else store_tile_bf16<2>(acc, QM, 1024, row0, col0, C_MEMQ, nullptr, nullptr);
        } else if (u.job == 1) store_tile_bf16<0>(acc, VDT, 32768, row0, u.pn * BM + cin, 1.f, nullptr, nullptr);
        else if (u.job == 2) store_tile_bf16<0>(acc, KM, 1024, row0, u.pn * BM + cin, 1.f, nullptr, nullptr);
        else store_tile_bf16<0>(acc, VMT, 4096, row0, u.pn * BM + cin, 1.f, nullptr, nullptr);
    }
};
struct EpiPlain {
    static constexpr bool PERM = true, AFTER_DRAIN = false;
    bf16_t* O; int ldc;
    __device__ __forceinline__ void operator()(const f32x4 (&acc)[2][2][4][2], const Unit& u, int wr, int wc, int fr, int fq) const {
        store_tile_bf16<0>(acc, O, ldc, u.pm * BM + wr * 64 + fr, u.pn * BM + wc * 32 + 8 * fq, 1.f, nullptr, nullptr);
    }
};
template <int MODE> struct EpiSplit {
    static constexpr bool PERM = true, AFTER_DRAIN = false;
    bf16_t *O0, *O1, *O2; const float* bias;
    __device__ __forceinline__ void operator()(const f32x4 (&acc)[2][2][4][2], const Unit& u, int wr, int wc, int fr, int fq) const {
        const int t = u.pn >> 2, cin = wc * 32 + 8 * fq, row0 = u.pm * BM + wr * 64 + fr, col0 = (u.pn & 3) * BM + cin; const float* bp = MODE == 3 ? bias + u.pn * BM + cin : nullptr;
        if (t == 0) store_tile_bf16<MODE>(acc, O0, 1024, row0, col0, 2.f, bp, nullptr);
        else if (t == 1) store_tile_bf16<MODE>(acc, O1, 1024, row0, col0, 2.f, bp, nullptr);
        else store_tile_bf16<MODE>(acc, O2, 1024, row0, col0, 2.f, bp, nullptr);
    }
};
struct EpiMerge {
    static constexpr bool PERM = true, AFTER_DRAIN = false;
    bf16_t* T; const bf16_t *G0, *G1, *G2;
    __device__ __forceinline__ void operator()(const f32x4 (&acc)[2][2][4][2], const Unit& u, int wr, int wc, int fr, int fq) const {
        const int row0 = u.pm * BM + wr * 64 + fr, col0 = u.pn * BM + wc * 32 + 8 * fq;
        if (u.job == 0) store_tile_bf16<4>(acc, T, 1024, row0, col0, (ABL_BR & 1) ? 0.f : SC_A, nullptr, G0);
        else if (u.job == 1) store_tile_bf16<5>(acc, T, 1024, row0, col0, (ABL_BR & 2) ? 0.f : SC_B, nullptr, G1);
        else store_tile_bf16<5>(acc, T, 1024, row0, col0, (ABL_BR & 4) ? 0.f : SC_C, nullptr, G2);
    }
};
struct EpiResid {
    static constexpr bool PERM = false, AFTER_DRAIN = false;
    const float* X; float* R; float alpha;
    __device__ __forceinline__ void operator()(const f32x4 (&acc)[2][2][4][2], const Unit& u, int wr, int wc, int fr, int fq) const {
        const int row0 = u.pm * BM + wr * 64 + fr, col0 = u.pn * BM + wc * 32 + 4 * fq;
#pragma unroll
        for (int ai = 0; ai < 2; ++ai)
#pragma unroll
            for (int m = 0; m < 4; ++m) { const size_t roff = (size_t)(row0 + ai * HALF + m * 16) * 1024 + col0;
#pragma unroll
                for (int bj = 0; bj < 2; ++bj)
#pragma unroll
                    for (int n = 0; n < 2; ++n) { const f32x4 xv = *(const f32x4*)(X + roff + bj * HALF + n * 16); *(f32x4*)(R + roff + bj * HALF + n * 16) = xv * alpha + (ABL_Y ? acc[ai][bj][m][n] * 0.f : acc[ai][bj][m][n]); } }
    }
};

template <class Epi, class Sched, bool ALIGN_EPI = false, bool SP2 = false>
__device__ __forceinline__ void gemm_phase(PG8_LAS unsigned char* lds, const Gemm g, const Sched& S, const Epi& E) {
    const int tid = threadIdx.x, wid = __builtin_amdgcn_readfirstlane(tid >> 6), lane = tid & 63, wr = wid >> 2, wc = wid & 3, fr = lane & 15, fq = lane >> 4;
    const int K = g.K, nt = K / BK;
    unsigned voffA[2], voffB[2];
#pragma unroll
    for (int i = 0; i < 2; ++i) { int R, C; stage_rc(tid * 16 + i * 8192, R, C); const int Rb = Epi::PERM ? ((R & ~31) + perm32(R & 31)) : R;
        voffA[i] = (unsigned)(R * K + C) * 2u; voffB[i] = (unsigned)(Rb * K + C) * 2u; }
    const size_t kstep = (size_t)(BK * 2);
    const size_t hstep = (size_t)HALF * K * 2;
    const size_t tstep = 2 * hstep;
    const unsigned ldsw = (unsigned)wid * 1024u;
    const int aoff = lds_byte(wr * 64 + fr, fq * 8), boff = lds_byte(wc * 32 + fr, fq * 8);
#define PG8_SA(b, h) (((b) * 2 + (h)) * HTB)
#define PG8_SB(b, h) ((4 + (b) * 2 + (h)) * HTB)
#define PG8_STAGE(bufoff, gbase, voff) do { _Pragma("unroll") for (int _i = 0; _i < 2; ++_i) \
        __builtin_amdgcn_global_load_lds((const unsigned*)((const char*)(gbase) + (voff)[_i]), (PG8_LAS unsigned*)(lds + (bufoff) + ldsw + _i * 8192), 16, 0, 0); } while (0)
#define PG8_LDA(dst, b, h) do { _Pragma("unroll") for (int m = 0; m < 4; ++m) _Pragma("unroll") for (int k = 0; k < 2; ++k) dst[m][k] = *(const PG8_LAS bf16x8*)(lds + PG8_SA(b, h) + aoff + m * 2048 + k * 1024); } while (0)
#define PG8_LDB(dst, b, h) do { _Pragma("unroll") for (int n = 0; n < 2; ++n) _Pragma("unroll") for (int k = 0; k < 2; ++k) dst[n][k] = *(const PG8_LAS bf16x8*)(lds + PG8_SB(b, h) + boff + n * 2048 + k * 1024); } while (0)
#define PG8_MMA(ai, bj, At, Bt) do { __builtin_amdgcn_s_setprio(1); _Pragma("unroll") for (int m = 0; m < 4; ++m) _Pragma("unroll") for (int n = 0; n < 2; ++n) _Pragma("unroll") for (int k = 0; k < 2; ++k) \
        acc[ai][bj][m][n] = __builtin_amdgcn_mfma_f32_16x16x32_bf16(Bt[n][k], At[m][k], acc[ai][bj][m][n], 0, 0, 0); __builtin_amdgcn_s_setprio(0); } while (0)
#define PG8_WAIT_V(n) asm volatile("s_waitcnt vmcnt(" #n ")" ::: "memory")
#define PG8_WAIT_L(n) asm volatile("s_waitcnt lgkmcnt(" #n ")" ::: "memory")
#define PG8_BAR __builtin_amdgcn_s_barrier()
#define PG8_SCHED __builtin_amdgcn_sched_barrier(0)
    Unit cur, nxt; int ui = 0;
    if (!S.next(0, cur)) return;
    f32x4 acc[2][2][4][2];
#pragma unroll
    for (int a = 0; a < 2; ++a)
#pragma unroll
        for (int b = 0; b < 2; ++b)
#pragma unroll
            for (int m = 0; m < 4; ++m)
#pragma unroll
                for (int n = 0; n < 2; ++n) acc[a][b][m][n] = (f32x4){0.f, 0.f, 0.f, 0.f};
    bf16x8 At[4][2], B0[2][2], B1[2][2];
    const char* cA = jobA(g, cur.job) + (size_t)cur.pm * tstep; const char* cB = jobB(g, cur.job) + (size_t)cur.pn * tstep;
    S.a_ready(cur);
    if constexpr (SP2) {
        PG8_STAGE(PG8_SB(0, 0), cB, voffB); PG8_STAGE(PG8_SB(0, 1), cB + hstep, voffB); PG8_STAGE(PG8_SA(0, 0), cA, voffA); PG8_STAGE(PG8_SA(0, 1), cA + hstep, voffA);
        if (wr == 1) PG8_BAR;
        PG8_WAIT_V(2); PG8_BAR;
        PG8_STAGE(PG8_SB(1, 0), cB + kstep, voffB); PG8_STAGE(PG8_SA(1, 0), cA + kstep, voffA); PG8_STAGE(PG8_SB(1, 1), cB + hstep + kstep, voffB);
        PG8_WAIT_V(6); PG8_BAR;
    } else {
        PG8_STAGE(PG8_SB(0, 0), cB, voffB); PG8_STAGE(PG8_SA(0, 0), cA, voffA); PG8_STAGE(PG8_SB(0, 1), cB + hstep, voffB); PG8_STAGE(PG8_SA(0, 1), cA + hstep, voffA);
        if (wr == 1) PG8_BAR;
        PG8_WAIT_V(4); PG8_BAR;
        PG8_STAGE(PG8_SB(1, 0), cB + kstep, voffB); PG8_STAGE(PG8_SA(1, 0), cA + kstep, voffA); PG8_STAGE(PG8_SB(1, 1), cB + hstep + kstep, voffB);
        PG8_WAIT_V(6); PG8_BAR;
    }
    for (;;) {
        const bool has_next = S.next(ui + 1, nxt);
        const char* nA = has_next ? jobA(g, nxt.job) + (size_t)nxt.pm * tstep : cA; const char* nB = has_next ? jobB(g, nxt.job) + (size_t)nxt.pn * tstep : cB;
        for (int t = 0; t < nt; t += 2) {
            const bool last = (t == nt - 2);
            const char* a1 = cA + (size_t)(t + 1) * kstep;
            const char* a2 = last ? nA : cA + (size_t)(t + 2) * kstep; const char* b2 = last ? nB : cB + (size_t)(t + 2) * kstep;
            const char* a3 = a2 + kstep; const char* b3 = b2 + kstep;
            if (last && has_next) S.a_ready(nxt);
            if constexpr (SP2) {
            PG8_LDB(B0, 0, 0); PG8_LDB(B1, 0, 1); PG8_SCHED; PG8_LDA(At, 0, 0); PG8_STAGE(PG8_SA(1, 1), a1 + hstep, voffA);
            PG8_WAIT_V(8); PG8_WAIT_L(0); PG8_BAR; PG8_MMA(0, 0, At, B0); PG8_MMA(0, 1, At, B1); PG8_BAR; PG8_SCHED;
            PG8_LDA(At, 0, 1); PG8_STAGE(PG8_SB(0, 0), b2, voffB); PG8_STAGE(PG8_SB(0, 1), b2 + hstep, voffB); PG8_STAGE(PG8_SA(0, 0), a2, voffA);
            PG8_WAIT_V(8); PG8_WAIT_L(0); PG8_BAR; PG8_MMA(1, 0, At, B0); PG8_MMA(1, 1, At, B1); PG8_BAR; PG8_SCHED;
            PG8_LDB(B0, 1, 0); PG8_LDB(B1, 1, 1); PG8_SCHED; PG8_LDA(At, 1, 0); PG8_STAGE(PG8_SA(0, 1), a2 + hstep, voffA);
            PG8_WAIT_V(8); PG8_WAIT_L(0); PG8_BAR; PG8_MMA(0, 0, At, B0); PG8_MMA(0, 1, At, B1); PG8_BAR; PG8_SCHED;
            PG8_LDA(At, 1, 1); PG8_STAGE(PG8_SB(1, 0), b3, voffB); PG8_STAGE(PG8_SB(1, 1), b3 + hstep, voffB); PG8_STAGE(PG8_SA(1, 0), a3, voffA);
            PG8_WAIT_V(8); PG8_WAIT_L(0); PG8_BAR; PG8_MMA(1, 0, At, B0); PG8_MMA(1, 1, At, B1); PG8_BAR; PG8_SCHED;
            } else {
            PG8_LDB(B0, 0, 0); PG8_SCHED; PG8_LDA(At, 0, 0); PG8_STAGE(PG8_SA(1, 1), a1 + hstep, voffA);
            PG8_WAIT_L(8); PG8_BAR; PG8_WAIT_L(0); PG8_MMA(0, 0, At, B0); PG8_BAR; PG8_SCHED;
            PG8_LDB(B1, 0, 1); PG8_STAGE(PG8_SB(0, 0), b2, voffB);
            PG8_BAR; PG8_WAIT_L(0); PG8_MMA(0, 1, At, B1); PG8_BAR;
            PG8_LDA(At, 0, 1); PG8_STAGE(PG8_SA(0, 0), a2, voffA);
            PG8_BAR; PG8_WAIT_L(0); PG8_MMA(1, 0, At, B0); PG8_BAR; PG8_SCHED;
            PG8_STAGE(PG8_SB(0, 1), b2 + hstep, voffB);
            PG8_WAIT_V(6); PG8_BAR; PG8_MMA(1, 1, At, B1); PG8_BAR;
            PG8_LDB(B0, 1, 0); PG8_SCHED; PG8_LDA(At, 1, 0); PG8_STAGE(PG8_SA(0, 1), a2 + hstep, voffA);
            PG8_WAIT_L(8); PG8_BAR; PG8_WAIT_L(0); PG8_MMA(0, 0, At, B0); PG8_BAR; PG8_SCHED;
            PG8_LDB(B1, 1, 1); PG8_STAGE(PG8_SB(1, 0), b3, voffB);
            PG8_BAR; PG8_WAIT_L(0); PG8_MMA(0, 1, At, B1); PG8_BAR;
            PG8_LDA(At, 1, 1); PG8_STAGE(PG8_SA(1, 0), a3, voffA);
            PG8_BAR; PG8_WAIT_L(0); PG8_MMA(1, 0, At, B0); PG8_BAR; PG8_SCHED;
            PG8_STAGE(PG8_SB(1, 1), b3 + hstep, voffB);
            PG8_WAIT_V(6); PG8_BAR; PG8_MMA(1, 1, At, B1); PG8_BAR;
            }
        }
        if constexpr (ALIGN_EPI) { if (wr == 0) PG8_BAR; }
        if constexpr (!Epi::AFTER_DRAIN) { E(acc, cur, wr, wc, fr, fq); S.done(cur); }
        if (!has_next) break;
#pragma unroll
        for (int a = 0; a < 2; ++a)
#pragma unroll
            for (int b = 0; b < 2; ++b)
#pragma unroll
                for (int m = 0; m < 4; ++m)
#pragma unroll
                    for (int n = 0; n < 2; ++n) acc[a][b][m][n] = (f32x4){0.f, 0.f, 0.f, 0.f};
        cur = nxt; cA = nA; cB = nB; ++ui;
        if constexpr (ALIGN_EPI) { if (wr == 1) PG8_BAR; }
    }
    PG8_WAIT_V(0);
    if constexpr (!ALIGN_EPI) { if (wr == 0) PG8_BAR; }
    PG8_BAR;
    if constexpr (Epi::AFTER_DRAIN) { E.fused(acc, cur, wr, wc, fr, fq, lds, wid, lane); S.done(cur); }
#undef PG8_SA
#undef PG8_SB
#undef PG8_STAGE
#undef PG8_LDA
#undef PG8_LDB
#undef PG8_MMA
#undef PG8_WAIT_V
#undef PG8_WAIT_L
#undef PG8_BAR
#undef PG8_SCHED
}
}
#ifndef MIXSC
#define MIXSC 1.f
#endif
#ifndef BIASSC
#define BIASSC 1.f
#endif

constexpr int NWAVES = 8;
constexpr int N_LAUNCHES = MK_N_LAUNCHES;
constexpr int PER_PHASE = 10;
constexpr int BATCH = 16, SEQ = 2048, DM = 1024, MTOK = BATCH * SEQ, MEML = 256, MMEM = BATCH * MEML;
constexpr int NEXP = 16384;
constexpr float ALPHA = 1.189207115002721f;
constexpr float LN_EPS = 1e-5f;
constexpr float LAM_INIT = 0.2f;
constexpr float LOG2E = 1.4426950408889634f;

constexpr size_t MiB = 1u << 20;
constexpr size_t WS_CTL = 0, CTL_ZERO_BYTES = 1 * MiB;
constexpr size_t WS_W1T = 1 * MiB;
constexpr size_t WS_WVDT = 11 * MiB;
constexpr size_t WS_WGT = 13 * MiB;
constexpr size_t WS_WMKT = 19 * MiB;
constexpr size_t WS_WMVT = 21 * MiB;
constexpr size_t WS_WBT = 23 * MiB;
constexpr size_t WS_WOT = 29 * MiB;
constexpr size_t WS_WPQ = 31 * MiB;
constexpr size_t WS_SKD = 35 * MiB;
constexpr size_t WS_WST = 43 * MiB;
constexpr size_t WS_A0 = 48 * MiB, ACT_BYTES = 64 * MiB;
constexpr size_t WS_END = WS_A0 + 7 * ACT_BYTES;
constexpr size_t DO_XB = 0, DO_MEMB = 64 * MiB, DO_KM = 72 * MiB, DO_VMT = 80 * MiB;
constexpr int CW_TMO = 0, CW_CODE = 1, CW_BAR = 4096;

constexpr int RING_OFF = 0, RING_BYTES = 135168;
constexpr int LDSCTL_OFF = RING_BYTES, MISC_OFF = LDSCTL_OFF + 320;
constexpr int LDS_BYTES = 147456;
static_assert(MISC_OFF + 128 <= LDS_BYTES, "LDS map");

#define GAS __attribute__((address_space(1)))
#define LAS __attribute__((address_space(3)))
typedef unsigned short bf16;
typedef unsigned v4u __attribute__((ext_vector_type(4)));
typedef unsigned v2u __attribute__((ext_vector_type(2)));
typedef float f32x4 __attribute__((ext_vector_type(4)));
typedef float f32x16 __attribute__((ext_vector_type(16)));
typedef short bf16x8 __attribute__((ext_vector_type(8)));
typedef __bf16 bf16x2_t __attribute__((ext_vector_type(2)));
typedef float f32x2_t __attribute__((ext_vector_type(2)));
typedef GAS unsigned gu32;
#define RLX_AGENT __ATOMIC_RELAXED, __HIP_MEMORY_SCOPE_AGENT
#define LDS_WAIT() asm volatile("s_waitcnt lgkmcnt(0)" ::: "memory")
#define VM_WAIT() asm volatile("s_waitcnt vmcnt(0)" ::: "memory")
__device__ __forceinline__ unsigned f2bf(float f) { unsigned u = __builtin_bit_cast(unsigned, f); return (u + 0x7fffu + ((u >> 16) & 1u)) >> 16; }
__device__ __forceinline__ unsigned pk2(float lo, float hi) { f32x2_t v = {lo, hi}; bf16x2_t b = __builtin_convertvector(v, bf16x2_t); return __builtin_bit_cast(unsigned, b); }
__device__ __forceinline__ float bflo(unsigned w) { return __uint_as_float(w << 16); }
__device__ __forceinline__ float bfhi(unsigned w) { return __uint_as_float(w & 0xffff0000u); }
__device__ __forceinline__ float dot2_bf16(unsigned a, unsigned b, float acc) { return __builtin_amdgcn_fdot2_f32_bf16(__builtin_bit_cast(bf16x2_t, a), __builtin_bit_cast(bf16x2_t, b), acc, false); }
__device__ __forceinline__ float wave_sum(float v) {
#pragma unroll
    for (int o = 1; o < 64; o <<= 1) v += __shfl_xor(v, o);
    return v;
}
__device__ __forceinline__ float gelu1(float v) { pg8::f32x2 r = pg8::gelu_pk((pg8::f32x2){v, v}); return r.x; }

#define XB_TMO      128
#define XB_XCNT(j)  (256  + 64 * (j))
#define XB_XSUB(j)  (1280 + 64 * (j))
#define XB_XGEN(j)  (2304 + 64 * (j))
#define XB_TOP      3328
#define XB_TOPGEN   3392
#define XCD_BAR_WORDS 3456
#define XB_SPIN_CAP (1u << 22)

__device__ __forceinline__ unsigned xb_ld(unsigned* p)              { return __hip_atomic_load(p, __ATOMIC_RELAXED, __HIP_MEMORY_SCOPE_AGENT); }
__device__ __forceinline__ unsigned xb_add(unsigned* p, unsigned v) { return __hip_atomic_fetch_add(p, v, __ATOMIC_RELAXED, __HIP_MEMORY_SCOPE_AGENT); }
__device__ __forceinline__ unsigned xb_xcc_id() { return (unsigned)__builtin_amdgcn_s_getreg((3 << 11) | 20) & 0xFu; }
#define XB_SPIN(cond, bar) do { unsigned _sp = 0; while (cond) { __builtin_amdgcn_s_sleep(1); \
    if ((++_sp & 255u) == 0u) { if (xb_ld(&(bar)[XB_TMO])) break; if (_sp > XB_SPIN_CAP) { atomicAdd(&(bar)[XB_TMO], 1u); break; } } } } while (0)

struct XcdBarrier { unsigned* bar; unsigned x; volatile LAS unsigned* st; };

__device__ __forceinline__ XcdBarrier xcd_barrier_post(unsigned* bar, volatile LAS unsigned* st) {
    XcdBarrier b; b.bar = bar; b.x = xb_xcc_id(); b.st = st;
    if (threadIdx.x == 0) (void)xb_add(&bar[XB_XCNT(b.x)], 1u);
    return b;
}
__device__ __forceinline__ void xcd_barrier_complete(unsigned* bar, unsigned x, unsigned& nloc, unsigned& nx) {
    const unsigned G = gridDim.x * gridDim.y * gridDim.z;
    unsigned sum, cnt, mine, sp = 0u;
    for (;;) {
        sum = 0u; cnt = 0u; mine = 0u;
#pragma unroll
        for (unsigned j = 0; j < 16; ++j) { const unsigned c = xb_ld(&bar[XB_XCNT(j)]); sum += c; cnt += (c > 0u) ? 1u : 0u; mine = (j == x) ? c : mine; }
        if (sum == G) break;
        __builtin_amdgcn_s_sleep(1);
        if ((++sp & 255u) == 0u) { if (xb_ld(&bar[XB_TMO])) break; if (sp > XB_SPIN_CAP) { atomicAdd(&bar[XB_TMO], 1u); break; } }
    }
    nloc = mine > 0u ? mine : 1u; nx = cnt > 0u ? cnt : 1u;
}
__device__ __forceinline__ void xcd_barrier(const XcdBarrier& b) {
    asm volatile("s_waitcnt vmcnt(0)" ::: "memory");
    __syncthreads();
    if (threadIdx.x == 0) {
        unsigned* bar = b.bar;
        __builtin_amdgcn_s_waitcnt(0);
        unsigned nloc = b.st[0], nx = b.st[1];
        if (nloc == 0u) { xcd_barrier_complete(bar, b.x, nloc, nx); b.st[0] = nloc; b.st[1] = nx; }
        const unsigned old = xb_add(&bar[XB_XSUB(b.x)], 1u);
        const unsigned gen = old / nloc;
        if (old + 1u == (gen + 1u) * nloc) {
            __builtin_amdgcn_fence(__ATOMIC_RELEASE, "agent");
            asm volatile("s_waitcnt vmcnt(0)" ::: "memory");
            const unsigned og = xb_add(&bar[XB_TOP], 1u);
            const unsigned tg = og / nx;
            if (og + 1u == (tg + 1u) * nx) xb_add(&bar[XB_TOPGEN], 1u);
            else XB_SPIN(xb_ld(&bar[XB_TOPGEN]) == tg, bar);
            __builtin_amdgcn_fence(__ATOMIC_ACQUIRE, "agent");
            xb_add(&bar[XB_XGEN(b.x)], 1u);
            asm volatile("s_waitcnt vmcnt(0)" ::: "memory");
        } else {
            XB_SPIN(xb_ld(&bar[XB_XGEN(b.x)]) == gen, bar);
            __builtin_amdgcn_fence(__ATOMIC_ACQUIRE, "agent");
            asm volatile("s_waitcnt vmcnt(0)" ::: "memory");
        }
    }
    __syncthreads();
}

struct Args { const float* in[26]; float* out; unsigned char* ws; int ph_lo, ph_hi, li, pad; };
struct Frame {
    LAS unsigned char* lds;
    volatile LAS unsigned* MISC;
    gu32* ctl;
    int tid, lane, wave;
    int vcu, G;
    unsigned char* ws; unsigned char* dout;
};
__device__ __forceinline__ bf16* wsb(const Frame& F, size_t off) { return (bf16*)(F.ws + off); }
__device__ __forceinline__ bf16* act(const Frame& F, int i) { return (bf16*)(F.ws + WS_A0 + (size_t)i * ACT_BYTES); }

__device__ __forceinline__ void p0_transpose_item(const float* W, int ldw, int col_off, int ncols, int K, bf16* WT, int row_off, LAS float* scr, int item, int lane) {
    const int nblk = ncols / 32, kb = item / nblk, nb = item % nblk, k0 = 64 * kb, n0 = 32 * nb;
#pragma unroll 8
    for (int i = 0; i < 32; ++i) { const int kk = 2 * i + (lane >> 5); scr[kk * 33 + (lane & 31)] = W[(size_t)(k0 + kk) * ldw + col_off + n0 + (lane & 31)]; }
    LDS_WAIT(); asm volatile("" ::: "memory");
    const int c = lane & 7;
#pragma unroll
    for (int j = 0; j < 4; ++j) { const int n = (lane >> 3) + 8 * j; const LAS float* s = scr + (8 * c) * 33 + n;
        v4u o; o.x = pk2(s[0 * 33], s[1 * 33]); o.y = pk2(s[2 * 33], s[3 * 33]); o.z = pk2(s[4 * 33], s[5 * 33]); o.w = pk2(s[6 * 33], s[7 * 33]);
        *(GAS v4u*)(WT + (size_t)(row_off + n0 + n) * K + k0 + 8 * c) = o; }
    LDS_WAIT(); asm volatile("" ::: "memory");
}
__device__ __forceinline__ void cvt_row_1024(const float* src, bf16* dst, int lane) {
    const GAS f32x4* xr = (const GAS f32x4*)src + lane;
    GAS v2u* o8 = (GAS v2u*)dst + lane;
    f32x4 v[4];
#pragma unroll
    for (int j = 0; j < 4; ++j) v[j] = xr[64 * j];
#pragma unroll
    for (int j = 0; j < 4; ++j) { v2u w; w.x = pk2(v[j].x, v[j].y); w.y = pk2(v[j].z, v[j].w); o8[64 * j] = w; }
}
__device__ __forceinline__ void p0_prologue(Frame& F, const Args& A) {
    LAS float* scr = (LAS float*)(F.lds + RING_OFF + F.wave * 16384);
    const int gw = F.vcu * NWAVES + F.wave, NGW = F.G * NWAVES;
    const float *w_in = A.in[2], *w_mkv = A.in[13], *w_gate = A.in[14], *w_br = A.in[16], *w_out = A.in[17];
    constexpr int I_IN0 = 16 * 128, I_INV = 16 * 32, I_INM = 16 * 32, I_G = 16 * 96, I_MK = 16 * 32, I_MV = 16 * 32, I_BR = 16 * 32, I_O = 16 * 32;
    constexpr int NT = I_IN0 + I_INV + I_INM + I_G + I_MK + I_MV + 3 * I_BR + I_O;
    for (int it = gw; it < NT; it += NGW) {
        int r = it;
        if (r < I_IN0) { p0_transpose_item(w_in, 6144, 0, 4096, 1024, wsb(F, WS_W1T), 0, scr, r, F.lane); continue; } r -= I_IN0;
        if (r < I_INV) { p0_transpose_item(w_in, 6144, 4096, 1024, 1024, wsb(F, WS_WVDT), 0, scr, r, F.lane); continue; } r -= I_INV;
        if (r < I_INM) { p0_transpose_item(w_in, 6144, 5120, 1024, 1024, wsb(F, WS_W1T), 4096, scr, r, F.lane); continue; } r -= I_INM;
        if (r < I_G) { p0_transpose_item(w_gate, 3072, 0, 3072, 1024, wsb(F, WS_WGT), 0, scr, r, F.lane); continue; } r -= I_G;
        if (r < I_MK) { p0_transpose_item(w_mkv, 2048, 0, 1024, 1024, wsb(F, WS_WMKT), 0, scr, r, F.lane); continue; } r -= I_MK;
        if (r < I_MV) { p0_transpose_item(w_mkv, 2048, 1024, 1024, 1024, wsb(F, WS_WMVT), 0, scr, r, F.lane); continue; } r -= I_MV;
        if (r < 3 * I_BR) { const int n = r / I_BR; p0_transpose_item(w_br + (size_t)n * 1024 * 1024, 1024, 0, 1024, 1024, wsb(F, WS_WBT) + (size_t)n * 1024 * 1024, 0, scr, r % I_BR, F.lane); continue; } r -= 3 * I_BR;
        p0_transpose_item(w_out, 1024, 0, 1024, 1024, wsb(F, WS_WOT), 0, scr, r, F.lane);
    }
    bf16* XB = (bf16*)(F.dout + DO_XB); bf16* MEMB = (bf16*)(F.dout + DO_MEMB);
    for (int m = gw; m < MTOK; m += NGW) cvt_row_1024(A.in[0] + (size_t)m * 1024, XB + (size_t)m * 1024, F.lane);
    for (int m = gw; m < MMEM; m += NGW) cvt_row_1024(A.in[1] + (size_t)m * 1024, MEMB + (size_t)m * 1024, F.lane);
    for (int m = gw; m < 2048; m += NGW) cvt_row_1024(A.in[20] + (size_t)m * 1024, wsb(F, WS_WPQ) + (size_t)m * 1024, F.lane);
    const float* sk = A.in[21];
    for (int r = gw; r < 2048; r += NGW) {
        const int cb = (r >> 7) << 7;
#pragma unroll
        for (int j = 0; j < 4; ++j) { const int c0 = 8 * (F.lane + 64 * j); v4u o = {0u, 0u, 0u, 0u};
            if (c0 >= cb && c0 < cb + 128) { const f32x4 a = *(const GAS f32x4*)(sk + (size_t)r * 128 + (c0 - cb)), b = *(const GAS f32x4*)(sk + (size_t)r * 128 + (c0 - cb) + 4);
                o.x = pk2(a.x, a.y); o.y = pk2(a.z, a.w); o.z = pk2(b.x, b.y); o.w = pk2(b.z, b.w); }
            *(GAS v4u*)(wsb(F, WS_SKD) + (size_t)r * 2048 + c0) = o; }
    }
}

#define MFMA32(a, b, c) __builtin_amdgcn_mfma_f32_32x32x16_bf16((a), (b), (c), 0, 0, 0)
__device__ __forceinline__ int crow(int r, int hi) { return (r & 3) + 8 * (r >> 2) + 4 * hi; }
__device__ __forceinline__ int swap23(int x) { return (x & ~12) | ((x & 4) << 1) | ((x & 8) >> 1); }
constexpr int P2_KBUF = 33792, P2_VBUF = 18432, P2_VROWB = 144;
constexpr int P2_K0 = 0, P2_V0 = 2 * P2_KBUF, P2_BT = P2_V0 + 2 * P2_VBUF, P2_SG = P2_BT + 512, P2_LAM = P2_SG + 512, P2_END = P2_LAM + 64;
static_assert(P2_END + 2 * 8192 <= RING_BYTES && 9216 + 3 * 8192 <= P2_KBUF, "P2 LDS");

template <int KSTEPS, bool BAND, bool QHOLD>
__device__ __forceinline__ void attn_pass(LAS unsigned char* lds, const bf16* qrow, const bf16* Kg, int kpitch, const bf16* Vg, int vpitch,
                                          int ntiles, int my_last, int band_first, int qpos, f32x16 (&O)[4], float& l_out) {
    constexpr int KROWB = KSTEPS * 32 + 16, KCH = KSTEPS * 2, KPT = (64 * KCH) / 512;
    static_assert(64 * KROWB <= P2_KBUF, "K tile");
    const int tid = threadIdx.x, lane = tid & 63, r = lane & 31, hi = lane >> 5;
    const LAS float* btab = (const LAS float*)(lds + P2_BT);
    v4u kreg[KPT], vreg[2];
    const bf16* ksrc[KPT]; int kdst[KPT]; const bf16* vsrc[2]; int vdst[2];
#pragma unroll
    for (int i = 0; i < KPT; ++i) { const int c = tid + 512 * i, row = c / KCH, part = c % KCH; ksrc[i] = Kg + (size_t)row * kpitch + part * 8; kdst[i] = ((row & 0x30) | swap23(row & 15)) * KROWB + part * 16; }
#pragma unroll
    for (int i = 0; i < 2; ++i) { const int c = tid + 512 * i, row = c >> 3, part = c & 7; vsrc[i] = Vg + (size_t)row * vpitch + part * 8; vdst[i] = row * P2_VROWB + part * 16; }
#pragma unroll
    for (int d = 0; d < 4; ++d) O[d] = f32x16{};
    float m_run = -1e30f, l_run = 0.f;
    bf16x8 qf[QHOLD ? KSTEPS : 1];
    if (QHOLD) {
#pragma unroll
        for (int ks = 0; ks < KSTEPS; ++ks) qf[QHOLD ? ks : 0] = *(const GAS bf16x8*)(qrow + ks * 16);
    }
#pragma unroll
    for (int i = 0; i < KPT; ++i) kreg[i] = *(const GAS v4u*)(ksrc[i]);
#pragma unroll
    for (int i = 0; i < 2; ++i) vreg[i] = *(const GAS v4u*)(vsrc[i]);
#pragma unroll
    for (int i = 0; i < KPT; ++i) *(LAS v4u*)(lds + P2_K0 + kdst[i]) = kreg[i];
#pragma unroll
    for (int i = 0; i < 2; ++i) *(LAS v4u*)(lds + P2_V0 + vdst[i]) = vreg[i];
    __syncthreads();
    for (int t = 0; t < ntiles; ++t) {
        const int cur = t & 1; const bool more = (t + 1 < ntiles);
        if (more) {
#pragma unroll
            for (int i = 0; i < KPT; ++i) kreg[i] = *(const GAS v4u*)(ksrc[i] + (size_t)(t + 1) * 64 * kpitch);
#pragma unroll
            for (int i = 0; i < 2; ++i) vreg[i] = *(const GAS v4u*)(vsrc[i] + (t + 1) * 64);
        }
        if (t <= my_last) {
            const LAS unsigned char* kb = lds + P2_K0 + cur * P2_KBUF + r * KROWB + hi * 16;
            const LAS unsigned char* vb = lds + P2_V0 + cur * P2_VBUF + r * P2_VROWB + hi * 16;
            f32x16 p0 = f32x16{}, p1 = f32x16{};
#pragma unroll
            for (int ks = 0; ks < KSTEPS; ++ks) {
                const bf16x8 a0 = *(const LAS bf16x8*)(kb + ks * 32), a1 = *(const LAS bf16x8*)(kb + 32 * KROWB + ks * 32);
                const bf16x8 qq = QHOLD ? qf[QHOLD ? ks : 0] : *(const GAS bf16x8*)(qrow + ks * 16);
                p0 = MFMA32(a0, qq, p0); p1 = MFMA32(a1, qq, p1);
            }
            if (BAND && t >= band_first) {
                const int kv0 = t * 64;
#pragma unroll
                for (int e = 0; e < 16; ++e) {
                    const int kl = swap23(crow(e, 0)) + 8 * hi;
                    const int rel0 = qpos - (kv0 + kl), rel1 = rel0 - 32;
                    const float b0 = btab[rel0 < 0 ? 0 : (rel0 > 127 ? 127 : rel0)], b1 = btab[rel1 < 0 ? 0 : (rel1 > 127 ? 127 : rel1)];
                    p0[e] = rel0 < 0 ? -1e30f : p0[e] + b0; p1[e] = rel1 < 0 ? -1e30f : p1[e] + b1;
                }
            }
            float mx = fmaxf(p0[0], p1[0]);
#pragma unroll
            for (int e = 1; e < 16; ++e) mx = fmaxf(mx, fmaxf(p0[e], p1[e]));
            mx = fmaxf(mx, __shfl_xor(mx, 32));
            const float m_new = fmaxf(m_run, mx), alpha = __builtin_amdgcn_exp2f(m_run - m_new);
            m_run = m_new;
            float ps = 0.f;
#pragma unroll
            for (int e = 0; e < 16; ++e) { p0[e] = __builtin_amdgcn_exp2f(p0[e] - m_new); p1[e] = __builtin_amdgcn_exp2f(p1[e] - m_new); ps += p0[e] + p1[e]; }
            l_run = l_run * alpha + ps;
#pragma unroll
            for (int d = 0; d < 4; ++d) O[d] = O[d] * alpha;
            bf16x8 pk[4];
#pragma unroll
            for (int s = 0; s < 2; ++s) {
                v4u w0, w1;
                w0.x = pk2(p0[8 * s + 0], p0[8 * s + 1]); w0.y = pk2(p0[8 * s + 2], p0[8 * s + 3]); w0.z = pk2(p0[8 * s + 4], p0[8 * s + 5]); w0.w = pk2(p0[8 * s + 6], p0[8 * s + 7]);
                w1.x = pk2(p1[8 * s + 0], p1[8 * s + 1]); w1.y = pk2(p1[8 * s + 2], p1[8 * s + 3]); w1.z = pk2(p1[8 * s + 4], p1[8 * s + 5]); w1.w = pk2(p1[8 * s + 6], p1[8 * s + 7]);
                pk[s] = __builtin_bit_cast(bf16x8, w0); pk[2 + s] = __builtin_bit_cast(bf16x8, w1);
            }
#pragma unroll
            for (int d = 0; d < 4; ++d)
#pragma unroll
                for (int s = 0; s < 4; ++s) { const bf16x8 a = *(const LAS bf16x8*)(vb + d * 32 * P2_VROWB + s * 32); O[d] = MFMA32(a, pk[s], O[d]); }
        }
        if (more) {
            const int nb = cur ^ 1;
#pragma unroll
            for (int i = 0; i < KPT; ++i) *(LAS v4u*)(lds + P2_K0 + nb * P2_KBUF + kdst[i]) = kreg[i];
#pragma unroll
            for (int i = 0; i < 2; ++i) *(LAS v4u*)(lds + P2_V0 + nb * P2_VBUF + vdst[i]) = vreg[i];
        }
        __syncthreads();
    }
    l_out = l_run + __shfl_xor(l_run, 32);
}

__device__ __forceinline__ void diff_unit(Frame& F, int b, int h, int qb) {
    const int lane = F.lane, r = lane & 31, hi = lane >> 5, wid = F.wave;
    const bf16 *QD = act(F, 2), *KD = act(F, 3), *VDT = act(F, 4); bf16* HB = act(F, 2);
    const int qw = qb * 256 + wid * 32, qpos = qw + r; const size_t row = (size_t)b * SEQ + qpos;
    const bf16* qrow = QD + row * 1024 + h * 128 + hi * 8;
    #ifdef ABL_NOSKIP
    const int ntiles = 4 * (qb + 1), my_last = ntiles - 1, band_first = 0;
#else
    const int ntiles = 4 * (qb + 1), my_last = (qw + 31) >> 6, band_first = (qw - 176) < 0 ? 0 : (qw - 176) >> 6;
#endif
    const bf16* Kb = KD + (size_t)b * SEQ * 1024 + h * 128; const bf16* Vb = VDT + (size_t)(h * 128) * MTOK + (size_t)b * SEQ;
    f32x16 O[4]; float l1, l2;
    attn_pass<4, true, false>(F.lds, qrow, Kb, 1024, Vb, MTOK, ntiles, my_last, band_first, qpos, O, l1);
    LAS unsigned* stash = (LAS unsigned*)(F.lds + (wid < 3 ? 9216 + wid * 8192 : wid < 6 ? P2_KBUF + 9216 + (wid - 3) * 8192 : P2_END + (wid - 6) * 8192));
    { const float inv = 1.0f / l1;
#pragma unroll
      for (int d = 0; d < 4; ++d)
#pragma unroll
          for (int e = 0; e < 8; ++e) stash[(d * 8 + e) * 64 + lane] = pk2(O[d][2 * e] * inv, O[d][2 * e + 1] * inv); }
    attn_pass<4, true, false>(F.lds, qrow + 64, Kb + 64, 1024, Vb, MTOK, ntiles, my_last, band_first, qpos, O, l2);
    const float lam = *(const LAS float*)(F.lds + P2_LAM), c2 = lam / l2;
    float ss = 0.f;
#pragma unroll
    for (int d = 0; d < 4; ++d)
#pragma unroll
        for (int e = 0; e < 8; ++e) { const unsigned o1 = stash[(d * 8 + e) * 64 + lane]; const float a = bflo(o1) - c2 * O[d][2 * e], c = bfhi(o1) - c2 * O[d][2 * e + 1]; O[d][2 * e] = a; O[d][2 * e + 1] = c; ss += a * a + c * c; }
    ss += __shfl_xor(ss, 32);
#ifdef ABL_QB
    const float rs = (qb == ABL_QB - 1) ? 0.f : __builtin_amdgcn_rsqf(ss * (1.0f / 128.0f) + LN_EPS) * (1.0f - LAM_INIT);
#else
    const float rs = __builtin_amdgcn_rsqf(ss * (1.0f / 128.0f) + LN_EPS) * (1.0f - LAM_INIT);
#endif
    const LAS float* sg = (const LAS float*)(F.lds + P2_SG);
#pragma unroll
    for (int d = 0; d < 4; ++d)
#pragma unroll
        for (int g = 0; g < 4; ++g) { const int dd = d * 32 + 8 * g + 4 * hi;
            v2u w; w.x = pk2(O[d][4 * g] * rs * sg[dd], O[d][4 * g + 1] * rs * sg[dd + 1]); w.y = pk2(O[d][4 * g + 2] * rs * sg[dd + 2], O[d][4 * g + 3] * rs * sg[dd + 3]);
            *(GAS v2u*)(HB + row * 1024 + h * 128 + dd) = w; }
    __syncthreads();
}
__device__ __forceinline__ void mem_unit(Frame& F, int b, int hm, int qb) {
    const int lane = F.lane, r = lane & 31, hi = lane >> 5, wid = F.wave;
    const bf16* QM = act(F, 5); bf16* HC = act(F, 6);
    const bf16* KM = (const bf16*)(F.dout + DO_KM); const bf16* VMT = (const bf16*)(F.dout + DO_VMT);
    const size_t row = (size_t)b * SEQ + qb * 256 + wid * 32 + r;
    const bf16* qrow = QM + row * 1024 + hm * 256 + hi * 8;
    const bf16* Kb = KM + (size_t)b * MEML * 1024 + hm * 256;
#pragma unroll 1
    for (int half = 0; half < 2; ++half) {
        const bf16* Vb = VMT + (size_t)(hm * 256 + half * 128) * MMEM + (size_t)b * MEML;
        f32x16 O[4]; float l;
        attn_pass<16, false, false>(F.lds, qrow, Kb, 1024, Vb, MMEM, 4, 3, 4, 0, O, l);
        const float inv = 1.0f / l;
#pragma unroll
        for (int d = 0; d < 4; ++d)
#pragma unroll
            for (int g = 0; g < 4; ++g) { const int dd = d * 32 + 8 * g + 4 * hi;
                v2u w; w.x = pk2(O[d][4 * g] * inv, O[d][4 * g + 1] * inv); w.y = pk2(O[d][4 * g + 2] * inv, O[d][4 * g + 3] * inv);
                *(GAS v2u*)(HC + row * 1024 + hm * 256 + half * 128 + dd) = w; }
    }
}
constexpr int SG_VNT = 0, SG_W = 34816, SG_ST = 69632, SG_ROWB = 272;
__device__ __forceinline__ void sgu_unit(Frame& F, const Args& A, int b, int chunk) {
    const int tid = F.tid, lane = F.lane, r = lane & 31, hi = lane >> 5, wid = F.wave;
    bf16* U = act(F, 0); const bf16* V = act(F, 1);
    const size_t t0 = (size_t)b * SEQ + chunk * 128;
    const float *lng = A.in[3], *lnb = A.in[4], *wsp = A.in[5], *bsp = A.in[6];
    LAS float* st = (LAS float*)(F.lds + SG_ST);
#pragma unroll 1
    for (int i = 0; i < 16; ++i) { const int s = wid * 16 + i; const bf16* vr = V + (t0 + s) * 1024;
        const v4u a = *(const GAS v4u*)(vr + lane * 8), c = *(const GAS v4u*)(vr + 512 + lane * 8);
        float x[16] = {bflo(a.x), bfhi(a.x), bflo(a.y), bfhi(a.y), bflo(a.z), bfhi(a.z), bflo(a.w), bfhi(a.w), bflo(c.x), bfhi(c.x), bflo(c.y), bfhi(c.y), bflo(c.z), bfhi(c.z), bflo(c.w), bfhi(c.w)};
        float sm = 0.f;
#pragma unroll
        for (int j = 0; j < 16; ++j) sm += x[j];
        const float mean = wave_sum(sm) * (1.0f / 1024.0f); float sq = 0.f;
#pragma unroll
        for (int j = 0; j < 16; ++j) { const float d = x[j] - mean; sq += d * d; }
        const float rstd = __builtin_amdgcn_rsqf(wave_sum(sq) * (1.0f / 1024.0f) + LN_EPS);
        if (lane == 0) { st[2 * s] = mean; st[2 * s + 1] = rstd; } }
    __syncthreads();
#pragma unroll 1
    for (int g = 0; g < 8; ++g) {
#pragma unroll
        for (int i = 0; i < 4; ++i) { const int c = tid + 512 * i, s = c >> 4, part = c & 15; const int ch = g * 128 + part * 8;
            const v4u a = *(const GAS v4u*)(V + (t0 + s) * 1024 + ch); const float mean = st[2 * s], rstd = st[2 * s + 1];
            const f32x4 g0 = *(const GAS f32x4*)(lng + ch), g1 = *(const GAS f32x4*)(lng + ch + 4), b0 = *(const GAS f32x4*)(lnb + ch), b1 = *(const GAS f32x4*)(lnb + ch + 4);
            const float x[8] = {bflo(a.x), bfhi(a.x), bflo(a.y), bfhi(a.y), bflo(a.z), bfhi(a.z), bflo(a.w), bfhi(a.w)};
            const float gg[8] = {g0.x, g0.y, g0.z, g0.w, g1.x, g1.y, g1.z, g1.w}, bb[8] = {b0.x, b0.y, b0.z, b0.w, b1.x, b1.y, b1.z, b1.w};
#pragma unroll
            for (int e = 0; e < 8; ++e) *(LAS unsigned short*)(F.lds + SG_VNT + (part * 8 + e) * SG_ROWB + s * 2) = (unsigned short)f2bf((x[e] - mean) * rstd * gg[e] + bb[e]); }
#pragma unroll
        for (int i = 0; i < 8; ++i) { const int c = tid + 512 * i, t = c >> 5, part = c & 31, s0 = part * 4;
            const f32x4 w = *(const GAS f32x4*)(wsp + ((size_t)g * 128 + t) * 128 + s0);
            v2u o; o.x = pk2(s0 <= t ? w.x : 0.f, s0 + 1 <= t ? w.y : 0.f); o.y = pk2(s0 + 2 <= t ? w.z : 0.f, s0 + 3 <= t ? w.w : 0.f);
            *(LAS v2u*)(F.lds + SG_W + t * SG_ROWB + part * 8) = o; }
        __syncthreads();
        const int dblk = wid >> 1;
        f32x16 acc[2] = {f32x16{}, f32x16{}};
#pragma unroll
        for (int j = 0; j < 2; ++j) { const int tblk = 2 * (wid & 1) + j;
#pragma unroll
#ifdef ABL_NOSKIP
            for (int ks = 0; ks < 8; ++ks) {
#else
            for (int ks = 0; ks < 8; ++ks) if (ks <= 2 * tblk + 1) {
#endif
                const bf16x8 a = *(const LAS bf16x8*)(F.lds + SG_VNT + (dblk * 32 + r) * SG_ROWB + ks * 32 + hi * 16);
                const bf16x8 bq = *(const LAS bf16x8*)(F.lds + SG_W + (tblk * 32 + r) * SG_ROWB + ks * 32 + hi * 16);
                acc[j] = MFMA32(a, bq, acc[j]); } }
#pragma unroll
        for (int j = 0; j < 2; ++j) { const int t = (2 * (wid & 1) + j) * 32 + r; const float bs = bsp[g * 128 + t] * BIASSC; bf16* up = U + (t0 + t) * 1024 + g * 128 + dblk * 32 + 4 * hi;
#pragma unroll
            for (int q = 0; q < 4; ++q) { const v2u uu = *(const GAS v2u*)(up + 8 * q);
                v2u o; o.x = pk2(bflo(uu.x) * (acc[j][4 * q] * MIXSC + bs), bfhi(uu.x) * (acc[j][4 * q + 1] * MIXSC + bs)); o.y = pk2(bflo(uu.y) * (acc[j][4 * q + 2] * MIXSC + bs), bfhi(uu.y) * (acc[j][4 * q + 3] * MIXSC + bs));
                *(GAS v2u*)(up + 8 * q) = o; } }
        __syncthreads();
    }
}
__device__ __forceinline__ int t5_bucket(int n) {
    if (n < 16) return n;
    int l = 16 + (int)(logf((float)n / 16.0f) / 2.0794415416798357f * 16.0f);
    return l < 31 ? l : 31;
}
__device__ __forceinline__ void p2_phase(Frame& F, const Args& A) {
    {
        LAS float* bt = (LAS float*)(F.lds + P2_BT); LAS float* sg = (LAS float*)(F.lds + P2_SG); LAS float* lm = (LAS float*)(F.lds + P2_LAM);
        if (F.tid < 128) sg[F.tid] = A.in[11][F.tid];
        if (F.wave == 2) { const float a = wave_sum(A.in[7][F.lane] * A.in[8][F.lane]), c = wave_sum(A.in[9][F.lane] * A.in[10][F.lane]); if (F.lane == 0) lm[0] = expf(a) - expf(c) + LAM_INIT; }
    }
    __syncthreads();
    for (int v = F.vcu; v < 256; v += F.G) {
        const int x = v >> 5, w = v & 31;
#pragma unroll 1
        for (int rd = 0; rd < 4; ++rd) {
            const int bh = 16 * x + 4 * rd + (w >> 3), qb = (rd & 1) ? 7 - (w & 7) : (w & 7), b = bh >> 3, h = bh & 7;
            { LAS float* bt = (LAS float*)(F.lds + P2_BT); const float* tab = A.in[12];
              if (F.tid < 128) bt[F.tid] = (tab[t5_bucket(F.tid) * 8 + h] - tab[31 * 8 + h]) * LOG2E; }
            __syncthreads();
#ifndef NO_DIFF
            diff_unit(F, b, h, qb);
#endif
        }
    }
    for (int v = F.vcu; v < 256; v += F.G) {
#pragma unroll 1
        for (int i = 0; i < 2; ++i) { const int id = 2 * v + i;
#ifndef NO_MEM
            mem_unit(F, id >> 5, (id >> 3) & 3, id & 7);
#endif
        }
    }
#ifndef NO_SGU
    for (int v = F.vcu; v < 256; v += F.G) sgu_unit(F, A, v >> 4, v & 15);
#endif
}

__device__ __forceinline__ void ln1_rows(Frame& F, const Args& A) {
    const int gw = F.vcu * NWAVES + F.wave, NGW = F.G * NWAVES;
    float* R = (float*)F.dout; bf16* X1B = act(F, 0); const float *g = A.in[18], *bb = A.in[19];
    f32x4 gv[4], bv[4];
#pragma unroll
    for (int j = 0; j < 4; ++j) { gv[j] = *(const GAS f32x4*)(g + 4 * F.lane + 256 * j); bv[j] = *(const GAS f32x4*)(bb + 4 * F.lane + 256 * j); }
    for (int m = gw; m < MTOK; m += NGW) {
        GAS f32x4* xr = (GAS f32x4*)(R + (size_t)m * 1024) + F.lane;
        f32x4 v[4]; float s = 0.f;
#pragma unroll
        for (int j = 0; j < 4; ++j) { v[j] = xr[64 * j]; s += (v[j].x + v[j].y) + (v[j].z + v[j].w); }
        const float mean = wave_sum(s) * (1.f / 1024.f); float s2 = 0.f;
#pragma unroll
        for (int j = 0; j < 4; ++j) { v[j] = v[j] - mean; s2 += (v[j].x * v[j].x + v[j].y * v[j].y) + (v[j].z * v[j].z + v[j].w * v[j].w); }
        const float rstd = __builtin_amdgcn_rsqf(wave_sum(s2) * (1.f / 1024.f) + LN_EPS);
        GAS v2u* o8 = (GAS v2u*)(X1B + (size_t)m * 1024) + F.lane;
#pragma unroll
        for (int j = 0; j < 4; ++j) { const f32x4 y = v[j] * rstd * gv[j] + bv[j]; xr[64 * j] = y; v2u w; w.x = pk2(y.x, y.y); w.y = pk2(y.z, y.w); o8[64 * j] = w; }
    }
}

constexpr int TK_ROWB = 528;
#define MED3(a, b, c) __builtin_amdgcn_fmed3f((a), (b), (c))
__device__ __forceinline__ void topk_phase(Frame& F) {
    const int lane = F.lane, p = lane & 31, half = lane >> 5;
    const int gw = F.vcu * NWAVES + F.wave, NGW = F.G * NWAVES;
    LAS unsigned char* tile = F.lds + RING_OFF + F.wave * (32 * TK_ROWB);
    int* IDX = (int*)(F.ws + WS_A0 + 3 * ACT_BYTES); float* GATE = (float*)(F.ws + WS_A0 + 3 * ACT_BYTES + 16 * MiB);
    for (int it = gw; it < (MTOK / 32) * 8; it += NGW) {
        const int h = it & 7, t0 = (it >> 3) * 32;
        const bf16* S = act(F, h < 4 ? 2 : 5) + (size_t)t0 * 1024 + (h & 3) * 256;
#pragma unroll
        for (int i = 0; i < 16; ++i) { const int row = 2 * i + half; const v4u v = *(const GAS v4u*)(S + (size_t)row * 1024 + p * 8); *(LAS v4u*)(tile + row * TK_ROWB + p * 16) = v; }
        LDS_WAIT(); asm volatile("" ::: "memory");
        float L[16];
#pragma unroll
        for (int i = 0; i < 16; ++i) L[i] = -INFINITY;
        const LAS unsigned char* myrow = tile + p * TK_ROWB + half * 256;
#pragma unroll 2
        for (int j = 0; j < 16; ++j) {
            const v4u w = *(const LAS v4u*)(myrow + j * 16);
            const unsigned ww[4] = {w.x, w.y, w.z, w.w};
#pragma unroll
            for (int e = 0; e < 8; ++e) {
                const unsigned bits = ((e & 1) ? (ww[e >> 1] & 0xffff0000u) : (ww[e >> 1] << 16)) | (unsigned)(j * 8 + e);
                const float v = __uint_as_float(bits);
#pragma unroll
                for (int i = 15; i >= 1; --i) L[i] = MED3(L[i - 1], L[i], v);
                L[0] = fmaxf(L[0], v);
            }
        }
        float A[16], Bv[16];
#pragma unroll
        for (int i = 0; i < 16; ++i) { const float o = __shfl_xor(L[i], 32); A[i] = half ? o : L[i]; Bv[i] = half ? L[i] : o; }
        LAS unsigned* mine = (LAS unsigned*)(tile + p * TK_ROWB + half * 256);
        asm volatile("" ::: "memory");
#pragma unroll
        for (int i = 0; i < 16; ++i) { mine[i] = __float_as_uint(A[i]) & 0x7fu; mine[16 + i] = __float_as_uint(Bv[i]) & 0x7fu; }
        float T[16];
#pragma unroll
        for (int i = 0; i < 16; ++i) T[i] = -INFINITY;
#pragma unroll
        for (int i = 0; i < 16; ++i)
#pragma unroll
            for (int j = 0; j < 16; ++j) if ((i + 1) * (j + 1) <= 16) {
                const float sum = __uint_as_float(__float_as_uint(A[i]) & 0xffff0000u) + __uint_as_float(__float_as_uint(Bv[j]) & 0xffff0000u);
                const float v = __uint_as_float((__float_as_uint(sum) & 0xffffff00u) | (unsigned)(i * 16 + j));
#pragma unroll
                for (int q = 15; q >= 1; --q) T[q] = MED3(T[q - 1], T[q], v);
                T[0] = fmaxf(T[0], v);
            }
        float e[16], den = 0.f; const float mxs = __uint_as_float(__float_as_uint(T[0]) & 0xffffff00u);
#pragma unroll
        for (int q = 0; q < 16; ++q) { e[q] = __expf(__uint_as_float(__float_as_uint(T[q]) & 0xffffff00u) - mxs); den += e[q]; }
        const float inv = 1.0f / den;
        LDS_WAIT(); asm volatile("" ::: "memory");
        int id8[8]; float g8[8];
#pragma unroll
        for (int q = 0; q < 8; ++q) {
            const float tv = half ? T[8 + q] : T[q]; const unsigned code = __float_as_uint(tv) & 0xffu;
            id8[q] = (int)(mine[code >> 4] * 128u + mine[16 + (code & 15u)]); g8[q] = (half ? e[8 + q] : e[q]) * inv;
        }
        const size_t o = (size_t)(t0 + p) * 128 + h * 16 + half * 8;
        *(GAS v4u*)(IDX + o) = (v4u){(unsigned)id8[0], (unsigned)id8[1], (unsigned)id8[2], (unsigned)id8[3]}; *(GAS v4u*)(IDX + o + 4) = (v4u){(unsigned)id8[4], (unsigned)id8[5], (unsigned)id8[6], (unsigned)id8[7]};
        *(GAS f32x4*)(GATE + o) = (f32x4){g8[0], g8[1], g8[2], g8[3]}; *(GAS f32x4*)(GATE + o + 4) = (f32x4){g8[4], g8[5], g8[6], g8[7]};
        LDS_WAIT(); asm volatile("" ::: "memory");
    }
}

__device__ __forceinline__ void peer_phase(Frame& F, const Args& A) {
    const int lane = F.lane;
    const int gw = F.vcu * NWAVES + F.wave, NGW = F.G * NWAVES;
    const int* IDX = (const int*)(F.ws + WS_A0 + 3 * ACT_BYTES); const float* GATE = (const float*)(F.ws + WS_A0 + 3 * ACT_BYTES + 16 * MiB);
    const bf16* PU = act(F, 1); const bf16* PV = act(F, 1) + (size_t)NEXP * 1024; const bf16* X1B = act(F, 0);
    float* X1 = (float*)F.dout; const float *g2 = A.in[24], *b2 = A.in[25];
    for (int m = gw; m < MTOK; m += NGW) {
        const int id0 = IDX[(size_t)m * 128 + lane], id1 = IDX[(size_t)m * 128 + 64 + lane];
        const float ga0 = GATE[(size_t)m * 128 + lane], ga1 = GATE[(size_t)m * 128 + 64 + lane];
        const v4u xa = *(const GAS v4u*)(X1B + (size_t)m * 1024 + lane * 8), xb = *(const GAS v4u*)(X1B + (size_t)m * 1024 + 512 + lane * 8);
        float dots[4];
#pragma unroll
        for (int blk = 0; blk < 4; ++blk) {
            const int idv = (blk >> 1) ? id1 : id0;
            float pr[32];
#pragma unroll
            for (int e = 0; e < 32; ++e) {
                const int row = __builtin_amdgcn_readlane(idv, (blk & 1) * 32 + e);
                const bf16* ur = PU + (size_t)row * 1024;
                const v4u a = *(const GAS v4u*)(ur + lane * 8), c = *(const GAS v4u*)(ur + 512 + lane * 8);
                float s0 = dot2_bf16(a.x, xa.x, 0.f), s1 = dot2_bf16(a.y, xa.y, 0.f);
                s0 = dot2_bf16(a.z, xa.z, s0); s1 = dot2_bf16(a.w, xa.w, s1);
                s0 = dot2_bf16(c.x, xb.x, s0); s1 = dot2_bf16(c.y, xb.y, s1);
                s0 = dot2_bf16(c.z, xb.z, s0); s1 = dot2_bf16(c.w, xb.w, s1);
                pr[e] = s0 + s1;
            }
#pragma unroll
            for (int s = 16; s >= 1; s >>= 1) {
                const bool up = (lane & s) != 0;
#pragma unroll
                for (int i = 0; i < s; ++i) { const float lo = pr[i], hv = pr[i + s]; const float send = up ? lo : hv, keep = up ? hv : lo; pr[i] = keep + __shfl_xor(send, s); }
            }
            dots[blk] = pr[0] + __shfl_xor(pr[0], 32);
        }
        float wgt[2];
        wgt[0] = ga0 * gelu1(lane < 32 ? dots[0] : dots[1]);
        wgt[1] = ga1 * gelu1(lane < 32 ? dots[2] : dots[3]);
        float y[16];
#pragma unroll
        for (int j = 0; j < 16; ++j) y[j] = 0.f;
#pragma unroll
        for (int blk = 0; blk < 2; ++blk) {
            const int idv = blk ? id1 : id0; const float wv = wgt[blk];
#pragma unroll 8
            for (int e = 0; e < 64; ++e) {
                const int row = __builtin_amdgcn_readlane(idv, e); const float w = __builtin_bit_cast(float, __builtin_amdgcn_readlane(__builtin_bit_cast(int, wv), e));
                const bf16* vr = PV + (size_t)row * 1024;
                const v4u a = *(const GAS v4u*)(vr + lane * 8), c = *(const GAS v4u*)(vr + 512 + lane * 8);
                y[0] += w * bflo(a.x); y[1] += w * bfhi(a.x); y[2] += w * bflo(a.y); y[3] += w * bfhi(a.y); y[4] += w * bflo(a.z); y[5] += w * bfhi(a.z); y[6] += w * bflo(a.w); y[7] += w * bfhi(a.w);
                y[8] += w * bflo(c.x); y[9] += w * bfhi(c.x); y[10] += w * bflo(c.y); y[11] += w * bfhi(c.y); y[12] += w * bflo(c.z); y[13] += w * bfhi(c.z); y[14] += w * bflo(c.w); y[15] += w * bfhi(c.w);
            }
        }
        float* xr = X1 + (size_t)m * 1024;
        f32x4 v[4]; v[0] = *(const GAS f32x4*)(xr + lane * 8); v[1] = *(const GAS f32x4*)(xr + lane * 8 + 4); v[2] = *(const GAS f32x4*)(xr + 512 + lane * 8); v[3] = *(const GAS f32x4*)(xr + 512 + lane * 8 + 4);
        float s = 0.f;
#pragma unroll
        for (int j = 0; j < 4; ++j) { v[j] = v[j] * ALPHA + (f32x4){y[4 * j], y[4 * j + 1], y[4 * j + 2], y[4 * j + 3]} * (ABL_PEER == 1 ? 0.f : ABL_PEER == 2 ? 0.5f : ABL_PEER == 3 ? 2.f : 1.f); s += (v[j].x + v[j].y) + (v[j].z + v[j].w); }
        const float mean = wave_sum(s) * (1.f / 1024.f); float s2 = 0.f;
#pragma unroll
        for (int j = 0; j < 4; ++j) { v[j] = v[j] - mean; s2 += (v[j].x * v[j].x + v[j].y * v[j].y) + (v[j].z * v[j].z + v[j].w * v[j].w); }
        const float rstd = __builtin_amdgcn_rsqf(wave_sum(s2) * (1.f / 1024.f) + LN_EPS);
#pragma unroll
        for (int j = 0; j < 4; ++j) { const int col = (j >> 1) * 512 + lane * 8 + (j & 1) * 4;
            const f32x4 gg = *(const GAS f32x4*)(g2 + col), bb = *(const GAS f32x4*)(b2 + col);
#ifdef ABL_LN2
            *(GAS f32x4*)(xr + col) = v[j] * rstd; }
#else
            *(GAS f32x4*)(xr + col) = v[j] * rstd * gg + bb; }
#endif
    }
}

__global__ void __launch_bounds__(NWAVES * 64, 2) mk_fwd(Args A) {
    extern __shared__ __attribute__((aligned(16))) unsigned char lds[];
    Frame F;
    F.lds = (LAS unsigned char*)lds;
    F.MISC = (volatile LAS unsigned*)(F.lds + MISC_OFF);
    F.tid = threadIdx.x; F.lane = F.tid & 63; F.wave = __builtin_amdgcn_readfirstlane(F.tid >> 6);
    F.G = gridDim.x; { const int bx = blockIdx.x; F.vcu = (F.G % 8 == 0) ? (bx % 8) * (F.G / 8) + bx / 8 : bx; }
    F.ws = A.ws; F.dout = (unsigned char*)A.out; F.ctl = (gu32*)(A.ws + WS_CTL);
    for (int u = F.tid; u < (LDS_BYTES - LDSCTL_OFF) / 4; u += NWAVES * 64) ((LAS unsigned*)(F.lds + LDSCTL_OFF))[u] = 0u;
    __syncthreads();
    XcdBarrier bar; bar.bar = (unsigned*)(F.ctl + CW_BAR); bar.x = 0; bar.st = nullptr;
    if (N_LAUNCHES != PER_PHASE) bar = xcd_barrier_post((unsigned*)(F.ctl + CW_BAR), F.MISC + 8);
#define GRID_BAR() do { if (N_LAUNCHES != PER_PHASE) xcd_barrier(bar); } while (0)
    const int lo = A.ph_lo, hi = A.ph_hi;
#ifndef MK_PHASE_MASK
#define MK_PHASE_MASK 0x3ff
#endif
#define IN(k) (((MK_PHASE_MASK >> (k)) & 1) && lo <= (k) && (k) < hi)
#define BOTH(k) (IN(k) && IN((k) + 1))
    const bf16* XB = (const bf16*)(F.dout + DO_XB);

    if (IN(0)) { p0_prologue(F, A); if (BOTH(0)) GRID_BAR(); }

    if (IN(1)) {
        { pg8::Gemm g{XB, wsb(F, WS_WVDT), (const bf16*)(F.dout + DO_MEMB), wsb(F, WS_WMVT), wsb(F, WS_W1T), XB, wsb(F, WS_WMKT), (const bf16*)(F.dout + DO_MEMB), 1024};
          pg8::MultiOrder S; S.init(F.G, (int)blockIdx.x, 128, 20, 4, 128, 16, 4, 4, 16);
          pg8::EpiP1 E{act(F, 0), act(F, 1), act(F, 2), act(F, 3), act(F, 5), act(F, 4), (bf16*)(F.dout + DO_KM), (bf16*)(F.dout + DO_VMT)};
          pg8::gemm_phase<pg8::EpiP1, pg8::MultiOrder, true, true>(F.lds + RING_OFF, g, S, E); }
        { pg8::Gemm g{wsb(F, WS_SKD), nullptr, nullptr, nullptr, wsb(F, WS_WPQ), nullptr, nullptr, nullptr, 2048};
          pg8::MultiOrder S; S.init(F.G, (int)blockIdx.x, 8, 4);
          pg8::EpiPlain E{wsb(F, WS_WST), 1024};
          pg8::gemm_phase<pg8::EpiPlain, pg8::MultiOrder, true, true>(F.lds + RING_OFF, g, S, E); }
        if (BOTH(1)) GRID_BAR();
    }

    if (IN(2)) { p2_phase(F, A); if (BOTH(2)) GRID_BAR(); }

    if (IN(3)) {
        pg8::Gemm g{XB, nullptr, nullptr, nullptr, wsb(F, WS_WGT), nullptr, nullptr, nullptr, 1024};
        pg8::MultiOrder S; S.init(F.G, (int)blockIdx.x, 128, 12);
#ifdef SWAPG
        pg8::EpiSplit<3> E{act(F, 3), act(F, 1), act(F, 4), A.in[15]};
#else
        pg8::EpiSplit<3> E{act(F, 1), act(F, 3), act(F, 4), A.in[15]};
#endif
        pg8::gemm_phase<pg8::EpiSplit<3>, pg8::MultiOrder, true, true>(F.lds + RING_OFF, g, S, E);
        if (BOTH(3)) GRID_BAR();
    }

    if (IN(4)) {
        pg8::Gemm g{act(F, 0), act(F, 2), act(F, 6), nullptr, wsb(F, WS_WBT), wsb(F, WS_WBT) + (size_t)1024 * 1024, wsb(F, WS_WBT) + (size_t)2 * 1024 * 1024, nullptr, 1024};
        pg8::MultiOrder S; S.init(F.G, (int)blockIdx.x, 128, 4, 128, 4, 128, 4);
        pg8::EpiMerge E{act(F, 5), act(F, 1), act(F, 3), act(F, 4)};
        pg8::gemm_phase<pg8::EpiMerge, pg8::MultiOrder, true, true>(F.lds + RING_OFF, g, S, E);
        if (BOTH(4)) GRID_BAR();
    }

    if (IN(5)) {
        pg8::Gemm g{act(F, 5), nullptr, nullptr, nullptr, wsb(F, WS_WOT), nullptr, nullptr, nullptr, 1024};
        pg8::MultiOrder S; S.init(F.G, (int)blockIdx.x, 128, 4);
        pg8::EpiResid E{A.in[0], (float*)F.dout, ALPHA};
        pg8::gemm_phase<pg8::EpiResid, pg8::MultiOrder, true, true>(F.lds + RING_OFF, g, S, E);
        const int gw = F.vcu * NWAVES + F.wave, NGW = F.G * NWAVES;
        bf16* PU = act(F, 1);
        for (int m = gw; m < 2 * NEXP; m += NGW) cvt_row_1024((m < NEXP ? A.in[22] : A.in[23] - (size_t)NEXP * 1024) + (size_t)m * 1024, PU + (size_t)m * 1024, F.lane);
        if (BOTH(5)) GRID_BAR();
    }

    if (IN(6)) { ln1_rows(F, A); if (BOTH(6)) GRID_BAR(); }

    if (IN(7)) {
        pg8::Gemm g{act(F, 0), nullptr, nullptr, nullptr, wsb(F, WS_WST), nullptr, nullptr, nullptr, 1024};
        pg8::MultiOrder S; S.init(F.G, (int)blockIdx.x, 128, 8);
        pg8::EpiSplit<0> E{act(F, 2), act(F, 5), act(F, 5), A.in[15]};
        pg8::gemm_phase<pg8::EpiSplit<0>, pg8::MultiOrder, true, true>(F.lds + RING_OFF, g, S, E);
        if (BOTH(7)) GRID_BAR();
    }

    if (IN(8)) { topk_phase(F); if (BOTH(8)) GRID_BAR(); }

    if (IN(9)) { peer_phase(F, A); }
#undef IN
#undef BOTH
}


extern "C" void kernel_launch(void* const* d_in, const int* in_sizes, int n_in, void* d_out, int out_size, void* d_ws, size_t ws_size, hipStream_t stream) {
    static int grid = 0;
    if (grid == 0) {
        if (n_in != 26 || in_sizes[0] != MTOK * DM || out_size != MTOK * DM || ws_size < WS_END) {
            fprintf(stderr, "kernel_launch: unexpected shapes (n_in %d, in0 %d, out %d, ws %zu; need ws >= %zu); nothing launched\n", n_in, n_in > 0 ? in_sizes[0] : -1, out_size, ws_size, (size_t)WS_END); grid = -1; return; }
        int dev = 0, cus = 0, per_cu = 0;
        if (hipGetDevice(&dev) != hipSuccess || hipDeviceGetAttribute(&cus, hipDeviceAttributeMultiprocessorCount, dev) != hipSuccess) { fprintf(stderr, "kernel_launch: device query failed\n"); grid = -1; return; }
        if (hipFuncSetAttribute((const void*)mk_fwd, hipFuncAttributeMaxDynamicSharedMemorySize, LDS_BYTES) != hipSuccess) { fprintf(stderr, "kernel_launch: hipFuncSetAttribute failed\n"); grid = -1; return; }
        if (hipOccupancyMaxActiveBlocksPerMultiprocessor(&per_cu, (const void*)mk_fwd, NWAVES * 64, LDS_BYTES) != hipSuccess || per_cu < 1) { fprintf(stderr, "kernel_launch: occupancy query reports %d workgroups per CU\n", per_cu); }
        (void)hipGetLastError();
        grid = cus;
    }
    if (grid < 0) return;
    if (hipMemsetAsync((char*)d_ws + WS_CTL, 0, CTL_ZERO_BYTES, stream) != hipSuccess) { fprintf(stderr, "kernel_launch: hipMemsetAsync failed\n"); return; }
    Args a{};
    for (int i = 0; i < 26; ++i) a.in[i] = (const float*)d_in[i];
    a.out = (float*)d_out; a.ws = (unsigned char*)d_ws;
#ifdef ABL_TWICE
    for (int rep = 0; rep < 2; ++rep) {
    if (rep) (void)hipMemsetAsync((char*)d_ws + WS_CTL, 0, CTL_ZERO_BYTES, stream);
#endif
#ifdef DBG
    {
        constexpr int last_phase = DBG == 1 ? 1 : DBG <= 4 ? 2 : DBG == 5 ? 3 : DBG == 6 ? 4 : DBG == 7 ? 5 : DBG == 8 ? 6 : DBG == 9 ? 7 : DBG == 10 ? 8 : 9;
        for (int li = 0; li <= last_phase; ++li) { a.ph_lo = li; a.ph_hi = li + 1; a.li = li; hipLaunchKernelGGL(mk_fwd, dim3(grid), dim3(NWAVES * 64), LDS_BYTES, stream, a); }
        DbgP P{}; for (int i = 0; i < 26; ++i) P.in[i] = (const float*)d_in[i]; P.ws = (unsigned char*)d_ws; P.dout = (unsigned char*)d_out; P.st = (float*)((char*)d_ws + 65536);
        if (DBG == 1) hipLaunchKernelGGL(chk_p1, dim3(375), dim3(256), 0, stream, P);
        if (DBG == 2) hipLaunchKernelGGL(chk_sgu, dim3(512), dim3(128), 0, stream, P);
        if (DBG == 3) hipLaunchKernelGGL(chk_diff, dim3(600), dim3(256), 0, stream, P);
        if (DBG == 4) hipLaunchKernelGGL(chk_mem, dim3(400), dim3(256), 0, stream, P);
        if (DBG == 5 || DBG == 6 || DBG == 7 || DBG == 9) hipLaunchKernelGGL(chk_gemm, dim3(150), dim3(256), 0, stream, P, (int)DBG);
        if (DBG == 8) hipLaunchKernelGGL(chk_ln1, dim3(128), dim3(256), 0, stream, P);
        if (DBG == 10) hipLaunchKernelGGL(chk_topk, dim3(16), dim3(256), 0, stream, P);
        if (DBG == 11) hipLaunchKernelGGL(chk_final, dim3(300), dim3(256), 0, stream, P);
        hipLaunchKernelGGL(dbg_encode, dim3(2048), dim3(256), 0, stream, (float*)d_out, (const float*)P.st, (int)DBG_PAIR);
        return;
    }
#endif
    const int nl = (N_LAUNCHES == PER_PHASE) ? PER_PHASE : 1;
    for (int li = 0; li < nl; ++li) {
        a.ph_lo = (N_LAUNCHES == PER_PHASE) ? li : 0; a.ph_hi = (N_LAUNCHES == PER_PHASE) ? li + 1 : PER_PHASE; a.li = li;
        hipLaunchKernelGGL(mk_fwd, dim3(grid), dim3(NWAVES * 64), LDS_BYTES, stream, a);
        const hipError_t le = hipPeekAtLastError();
        if (le != hipSuccess) { fprintf(stderr, "kernel_launch: launch %d failed: %s\n", li, hipGetErrorName(le)); break; }
    }
#ifdef ABL_TWICE
    }
#endif
}
```

```cpp
#include <hip/hip_runtime.h>
#include <cstdio>
#include <cstdint>
#include <cmath>

#ifndef SC_A
#define SC_A 1.f
#endif
#ifndef SC_B
#define SC_B 1.f
#endif
#ifndef SC_C
#define SC_C 1.f
#endif
#ifndef ABL_BR
#define ABL_BR 0
#endif
#ifndef ABL_PEER
#define ABL_PEER 0
#endif
#ifndef ABL_Y
#define ABL_Y 0
#endif
#ifdef DBG
#define MK_N_LAUNCHES 10
#ifndef DBG_PAIR
#define DBG_PAIR 0
#endif
#endif
#ifndef MK_N_LAUNCHES
#define MK_N_LAUNCHES 1
#endif

namespace pg8 {
#define PG8_LAS __attribute__((address_space(3)))
typedef unsigned short bf16_t;
typedef short bf16x8 __attribute__((ext_vector_type(8)));
typedef float f32x4 __attribute__((ext_vector_type(4)));
typedef unsigned u32x4 __attribute__((ext_vector_type(4)));
typedef unsigned u32x2 __attribute__((ext_vector_type(2)));
constexpr int BM = 256, BK = 64, HALF = 128, HTB = HALF * BK * 2  , STAGE_BYTES = 8 * HTB, NXCD = 8, WGM = 8;

__host__ __device__ __forceinline__ int lds_byte(int r, int c) { const int st = (r >> 4) * 2 + (c >> 5), rr = r & 15, cc = c & 31, ob = rr * 64 + cc * 2; return st * 1024 + (ob ^ (((ob >> 9) & 1) << 5)); }
__host__ __device__ __forceinline__ void stage_rc(int b, int& R, int& C) { const int st = b / 1024, sb = b % 1024, swz = sb ^ (((sb >> 9) & 1) << 5); R = (st >> 1) * 16 + swz / 64; C = (st & 1) * 32 + (swz % 64) / 2; }
__host__ __device__ __forceinline__ int perm32(int rho) { const int n = rho >> 4, i = rho & 15; return 8 * (i >> 2) + 4 * n + (i & 3); }

struct Unit { int pm, pn, job; };
struct Gemm { const bf16_t *A0, *A1, *A2, *A3; const bf16_t *B0, *B1, *B2, *B3; int K; };
__device__ __forceinline__ const char* jobA(const Gemm& g, int j) { return (const char*)(j == 0 ? g.A0 : j == 1 ? g.A1 : j == 2 ? g.A2 : g.A3); }
__device__ __forceinline__ const char* jobB(const Gemm& g, int j) { return (const char*)(j == 0 ? g.B0 : j == 1 ? g.B1 : j == 2 ? g.B2 : g.B3); }

struct MultiOrder {
    int nM0, nN0, nM1, nN1, nM2, nN2, nM3, nN3, s1, s2, s3, s4, G, c;
    __device__ void init(int G_, int c_, int m0, int n0, int m1 = 0, int n1 = 0, int m2 = 0, int n2 = 0, int m3 = 0, int n3 = 0) {
        nM0 = m0; nN0 = n0; nM1 = m1; nN1 = n1; nM2 = m2; nN2 = n2; nM3 = m3; nN3 = n3; s1 = m0 * n0; s2 = s1 + m1 * n1; s3 = s2 + m2 * n2; s4 = s3 + m3 * n3; G = G_; c = c_; }
    __device__ bool next(int i, Unit& u) const {
        const long L = (long)i * G + c; if (L >= s4) return false;
        int nM, nN, loc;
        if (L < s1) { u.job = 0; nM = nM0; nN = nN0; loc = (int)L; }
        else if (L < s2) { u.job = 1; nM = nM1; nN = nN1; loc = (int)L - s1; }
        else if (L < s3) { u.job = 2; nM = nM2; nN = nN2; loc = (int)L - s2; }
        else { u.job = 3; nM = nM3; nN = nN3; loc = (int)L - s3; }
        const int nwg = nM * nN; int wgid = loc; { const int q = nwg / NXCD, r = nwg % NXCD, xcd = wgid % NXCD, off = wgid / NXCD; wgid = (xcd < r ? xcd * (q + 1) : r * (q + 1) + (xcd - r) * q) + off; }
        const int nig = WGM * nN, gid = wgid / nig, fm = gid * WGM, gsz = (nM - fm) < WGM ? (nM - fm) : WGM;
        u.pm = fm + ((wgid % nig) % gsz); u.pn = (wgid % nig) / gsz; return true;
    }
    __device__ __forceinline__ void a_ready(const Unit&) const {}
    __device__ __forceinline__ void done(const Unit&) const {}
};

typedef float f32x2 __attribute__((ext_vector_type(2)));
typedef __bf16 bf16x2v __attribute__((ext_vector_type(2)));
__device__ __forceinline__ unsigned cvt_pk_bf16(float lo, float hi) { f32x2 v = {lo, hi}; bf16x2v b = __builtin_convertvector(v, bf16x2v); return __builtin_bit_cast(unsigned, b); }
__device__ __forceinline__ f32x2 gelu_pk(f32x2 v) {
    const f32x2 av = __builtin_elementwise_abs(v), d = av * 0.2316418882f + 1.0f;
    f32x2 t; t.x = __builtin_amdgcn_rcpf(d.x); t.y = __builtin_amdgcn_rcpf(d.y);
    f32x2 q = t * 0.5307027145f + (-0.7265760135f); q = q * t + 0.7107068705f; q = q * t + (-0.142248368f); q = q * t + 0.127414796f; q = q * t;
    const f32x2 s = (v * v) * (-0.72134752044f);
    f32x2 e; e.x = __builtin_amdgcn_exp2f(s.x); e.y = __builtin_amdgcn_exp2f(s.y);
    const f32x2 m = v * (q * e), r = v - m;
    f32x2 o; o.x = v.x < 0.f ? m.x : r.x; o.y = v.y < 0.f ? m.y : r.y; return o;
}
__device__ __forceinline__ float bf_lo(unsigned w) { return __uint_as_float(w << 16); }
__device__ __forceinline__ float bf_hi(unsigned w) { return __uint_as_float(w & 0xffff0000u); }
__device__ __forceinline__ float sigmoidf_(float x) { return __builtin_amdgcn_rcpf(1.0f + __builtin_amdgcn_exp2f(-1.4426950408889634f * x)); }

template <int MODE>
__device__ __forceinline__ void store_tile_bf16(const f32x4 (&acc)[2][2][4][2], bf16_t* base, int ldc, int row0, int col0, float sc, const float* bias, const bf16_t* gate) {
    f32x4 bv[2][2];
    if (MODE == 3) {
#pragma unroll
        for (int bj = 0; bj < 2; ++bj)
#pragma unroll
            for (int n = 0; n < 2; ++n) bv[bj][n] = *(const f32x4*)(bias + bj * HALF + 4 * n);
    }
#pragma unroll
    for (int ai = 0; ai < 2; ++ai)
#pragma unroll
        for (int m = 0; m < 4; ++m) { const size_t roff = (size_t)(row0 + ai * HALF + m * 16) * ldc + col0;
#pragma unroll
            for (int bj = 0; bj < 2; ++bj) { f32x4 v0 = acc[ai][bj][m][0], v1 = acc[ai][bj][m][1];
                if (MODE == 1) { f32x2 a = gelu_pk((f32x2){v0[0], v0[1]}), b = gelu_pk((f32x2){v0[2], v0[3]}), c = gelu_pk((f32x2){v1[0], v1[1]}), d = gelu_pk((f32x2){v1[2], v1[3]});
                    v0 = (f32x4){a.x, a.y, b.x, b.y}; v1 = (f32x4){c.x, c.y, d.x, d.y}; }
                if (MODE == 2) { v0 = v0 * sc; v1 = v1 * sc; }
#ifdef ABL_SNOISE
                if (MODE == 0 && sc == 2.f) { const unsigned hsh = (unsigned)(roff + bj * HALF) * 2654435761u;
#pragma unroll
                    for (int q = 0; q < 4; ++q) { const unsigned h0 = (hsh + q * 0x9E3779B9u) * 1664525u + 1013904223u, h1 = h0 * 1664525u + 1013904223u;
                        v0[q] += ((float)(h0 >> 16) * (1.f / 65536.f) - 0.5f) * 0.07f; v1[q] += ((float)(h1 >> 16) * (1.f / 65536.f) - 0.5f) * 0.07f; } }
#endif
                if (MODE == 3) { v0 = v0 + bv[bj][0]; v1 = v1 + bv[bj][1];
                    v0 = (f32x4){sigmoidf_(v0[0]), sigmoidf_(v0[1]), sigmoidf_(v0[2]), sigmoidf_(v0[3])}; v1 = (f32x4){sigmoidf_(v1[0]), sigmoidf_(v1[1]), sigmoidf_(v1[2]), sigmoidf_(v1[3])}; }
                if (MODE == 4 || MODE == 5) { const u32x4 g = *(const u32x4*)(gate + roff + bj * HALF); v0 = v0 * sc; v1 = v1 * sc;
                    v0 = v0 * (f32x4){bf_lo(g.x), bf_hi(g.x), bf_lo(g.y), bf_hi(g.y)}; v1 = v1 * (f32x4){bf_lo(g.z), bf_hi(g.z), bf_lo(g.w), bf_hi(g.w)};
                    if (MODE == 5) { const u32x4 t = __builtin_nontemporal_load((const u32x4*)(base + roff + bj * HALF));
                        v0 = v0 + (f32x4){bf_lo(t.x), bf_hi(t.x), bf_lo(t.y), bf_hi(t.y)}; v1 = v1 + (f32x4){bf_lo(t.z), bf_hi(t.z), bf_lo(t.w), bf_hi(t.w)}; } }
                u32x4 w; w.x = cvt_pk_bf16(v0[0], v0[1]); w.y = cvt_pk_bf16(v0[2], v0[3]); w.z = cvt_pk_bf16(v1[0], v1[1]); w.w = cvt_pk_bf16(v1[2], v1[3]);
                *(u32x4*)(base + roff + bj * HALF) = w; } }
}

constexpr float C_DIFF = 0.125f * 1.4426950408889634f;
constexpr float C_MEMQ = 0.0625f * 1.4426950408889634f;

struct EpiP1 {
    static constexpr bool PERM = true, AFTER_DRAIN = false;
    bf16_t *U, *V, *QD, *KD, *QM, *VDT, *KM, *VMT;
    __device__ __forceinline__ void operator()(const f32x4 (&acc)[2][2][4][2], const Unit& u, int wr, int wc, int fr, int fq) const {
        const int row0 = u.pm * BM + wr * 64 + fr, cin = wc * 32 + 8 * fq;
        if (u.job == 0) { const int t = u.pn >> 2, col0 = (u.pn & 3) * BM + cin;
            if (t == 0) store_tile_bf16<1>(acc, U, 1024, row0, col0, 1.f, nullptr, nullptr);
            else if (t == 1) store_tile_bf16<1>(acc, V, 1024, row0, col0, 1.f, nullptr, nullptr);
            else if (t == 2) store_tile_bf16<2>(acc, QD, 1024, row0, col0, C_DIFF, nullptr, nullptr);
            else if (t == 3) store_tile_bf16<0>(acc, KD, 1024, row0, col0, 1.f, nullptr, nullptr);
            else store_tile_bf16<2>(acc, QM, 1024, row0, col0, C_MEMQ, nullptr, nullptr);
        } else if (u.job == 1) store_tile_bf16<0>(acc, VDT, 32768, row0, u.pn * BM + cin, 1.f, nullptr, nullptr);
        else if (u.job == 2) store_tile_bf16<0>(acc, KM, 1024, row0, u.pn * BM + cin, 1.f, nullptr, nullptr);
        else store_tile_bf16<0>(acc, VMT, 4096, row0, u.pn * BM + cin, 1.f, nullptr, nullptr);
    }
};
struct EpiPlain {
    static constexpr bool PERM = true, AFTER_DRAIN = false;
    bf16_t* O; int ldc;
    __device__ __forceinline__ void operator()(const f32x4 (&acc)[2][2][4][2], const Unit& u, int wr, int wc, int fr, int fq) const {
        store_tile_bf16<0>(acc, O, ldc, u.pm * BM + wr * 64 + fr, u.pn * BM + wc * 32 + 8 * fq, 1.f, nullptr, nullptr);
    }
};
template <int MODE> struct EpiSplit {
    static constexpr bool PERM = true, AFTER_DRAIN = false;
    bf16_t *O0, *O1, *O2; const float* bias;
    __device__ __forceinline__ void operator()(const f32x4 (&acc)[2][2][4][2], const Unit& u, int wr, int wc, int fr, int fq) const {
        const int t = u.pn >> 2, cin = wc * 32 + 8 * fq, row0 = u.pm * BM + wr * 64 + fr, col0 = (u.pn & 3) * BM + cin; const float* bp = MODE == 3 ? bias + u.pn * BM + cin : nullptr;
        if (t == 0) store_tile_bf16<MODE>(acc, O0, 1024, row0, col0, 2.f, bp, nullptr);
        else if (t == 1) store_tile_bf16<MODE>(acc, O1, 1024, row0, col0, 2.f, bp, nullptr);
        else store_tile_bf16<MODE>(acc, O2, 1024, row0, col0, 2.f, bp, nullptr);
    }
};
struct EpiMerge {
    static constexpr bool PERM = true, AFTER_DRAIN = false;
    bf16_t* T; const bf16_t *G0, *G1, *G2;
    __device__ __forceinline__ void operator()(const f32x4 (&acc)[2][2][4][2], const Unit& u, int wr, int wc, int fr, int fq) const {
        const int row0 = u.pm * BM + wr * 64 + fr, col0 = u.pn * BM + wc * 32 + 8 * fq;
        if (u.job == 0) store_tile_bf16<4>(acc, T, 1024, row0, col0, (ABL_BR & 1) ? 0.f : SC_A, nullptr, G0);
        else if (u.job == 1) store_tile_bf16<5>(acc, T, 1024, row0, col0, (ABL_BR & 2) ? 0.f : SC_B, nullptr, G1);
        else store_tile_bf16<5>(acc, T, 1024, row0, col0, (ABL_BR & 4) ? 0.f : SC_C, nullptr, G2);
    }
};
struct EpiResid {
    static constexpr bool PERM = false, AFTER_DRAIN = false;
    const float* X; float* R; float alpha;
    __device__ __forceinline__ void operator()(const f32x4 (&acc)[2][2][4][2], const Unit& u, int wr, int wc, int fr, int fq) const {
        const int row0 = u.pm * BM + wr * 64 + fr, col0 = u.pn * BM + wc * 32 + 4 * fq;
#pragma unroll
        for (int ai = 0; ai < 2; ++ai)
#pragma unroll
            for (int m = 0; m < 4; ++m) { const size_t roff = (size_t)(row0 + ai * HALF + m * 16) * 1024 + col0;
#pragma unroll
                for (int bj = 0; bj < 2; ++bj)
#pragma unroll
                    for (int n = 0; n < 2; ++n) { const f32x4 xv = *(const f32x4*)(X + roff + bj * HALF + n * 16); *(f32x4*)(R + roff + bj * HALF + n * 16) = xv * alpha + (ABL_Y ? acc[ai][bj][m][n] * 0.f : acc[ai][bj][m][n]); } }
    }
};

template <class Epi, class Sched, bool ALIGN_EPI = false, bool SP2 = false>
__device__ __forceinline__ void gemm_phase(PG8_LAS unsigned char* lds, const Gemm g, const Sched& S, const Epi& E) {
    const int tid = threadIdx.x, wid = __builtin_amdgcn_readfirstlane(tid >> 6), lane = tid & 63, wr = wid >> 2, wc = wid & 3, fr = lane & 15, fq = lane >> 4;
    const int K = g.K, nt = K / BK;
    unsigned voffA[2], voffB[2];
#pragma unroll
    for (int i = 0; i < 2; ++i) { int R, C; stage_rc(tid * 16 + i * 8192, R, C); const int Rb = Epi::PERM ? ((R & ~31) + perm32(R & 31)) : R;
        voffA[i] = (unsigned)(R * K + C) * 2u; voffB[i] = (unsigned)(Rb * K + C) * 2u; }
    const size_t kstep = (size_t)(BK * 2);
    const size_t hstep = (size_t)HALF * K * 2;
    const size_t tstep = 2 * hstep;
    const unsigned ldsw = (unsigned)wid * 1024u;
    const int aoff = lds_byte(wr * 64 + fr, fq * 8), boff = lds_byte(wc * 32 + fr, fq * 8);
#define PG8_SA(b, h) (((b) * 2 + (h)) * HTB)
#define PG8_SB(b, h) ((4 + (b) * 2 + (h)) * HTB)
#define PG8_STAGE(bufoff, gbase, voff) do { _Pragma("unroll") for (int _i = 0; _i < 2; ++_i) \
        __builtin_amdgcn_global_load_lds((const unsigned*)((const char*)(gbase) + (voff)[_i]), (PG8_LAS unsigned*)(lds + (bufoff) + ldsw + _i * 8192), 16, 0, 0); } while (0)
#define PG8_LDA(dst, b, h) do { _Pragma("unroll") for (int m = 0; m < 4; ++m) _Pragma("unroll") for (int k = 0; k < 2; ++k) dst[m][k] = *(const PG8_LAS bf16x8*)(lds + PG8_SA(b, h) + aoff + m * 2048 + k * 1024); } while (0)
#define PG8_LDB(dst, b, h) do { _Pragma("unroll") for (int n = 0; n < 2; ++n) _Pragma("unroll") for (int k = 0; k < 2; ++k) dst[n][k] = *(const PG8_LAS bf16x8*)(lds + PG8_SB(b, h) + boff + n * 2048 + k * 1024); } while (0)
#define PG8_MMA(ai, bj, At, Bt) do { __builtin_amdgcn_s_setprio(1); _Pragma("unroll") for (int m = 0; m < 4; ++m) _Pragma("unroll") for (int n = 0; n < 2; ++n) _Pragma("unroll") for (int k = 0; k < 2; ++k) \
        acc[ai][bj][m][n] = __builtin_amdgcn_mfma_f32_16x16x32_bf16(Bt[n][k], At[m][k], acc[ai][bj][m][n], 0, 0, 0); __builtin_amdgcn_s_setprio(0); } while (0)
#define PG8_WAIT_V(n) asm volatile("s_waitcnt vmcnt(" #n ")" ::: "memory")
#define PG8_WAIT_L(n) asm volatile("s_waitcnt lgkmcnt(" #n ")" ::: "memory")
#define PG8_BAR __builtin_amdgcn_s_barrier()
#define PG8_SCHED __builtin_amdgcn_sched_barrier(0)
    Unit cur, nxt; int ui = 0;
    if (!S.next(0, cur)) return;
    f32x4 acc[2][2][4][2];
#pragma unroll
    for (int a = 0; a < 2; ++a)
#pragma unroll
        for (int b = 0; b < 2; ++b)
#pragma unroll
            for (int m = 0; m < 4; ++m)
#pragma unroll
                for (int n = 0; n < 2; ++n) acc[a][b][m][n] = (f32x4){0.f, 0.f, 0.f, 0.f};
    bf16x8 At[4][2], B0[2][2], B1[2][2];
    const char* cA = jobA(g, cur.job) + (size_t)cur.pm * tstep; const char* cB = jobB(g, cur.job) + (size_t)cur.pn * tstep;
    S.a_ready(cur);
    if constexpr (SP2) {
        PG8_STAGE(PG8_SB(0, 0), cB, voffB); PG8_STAGE(PG8_SB(0, 1), cB + hstep, voffB); PG8_STAGE(PG8_SA(0, 0), cA, voffA); PG8_STAGE(PG8_SA(0, 1), cA + hstep, voffA);
        if (wr == 1) PG8_BAR;
        PG8_WAIT_V(2); PG8_BAR;
        PG8_STAGE(PG8_SB(1, 0), cB + kstep, voffB); PG8_STAGE(PG8_SA(1, 0), cA + kstep, voffA); PG8_STAGE(PG8_SB(1, 1), cB + hstep + kstep, voffB);
        PG8_WAIT_V(6); PG8_BAR;
    } else {
        PG8_STAGE(PG8_SB(0, 0), cB, voffB); PG8_STAGE(PG8_SA(0, 0), cA, voffA); PG8_STAGE(PG8_SB(0, 1), cB + hstep, voffB); PG8_STAGE(PG8_SA(0, 1), cA + hstep, voffA);
        if (wr == 1) PG8_BAR;
        PG8_WAIT_V(4); PG8_BAR;
        PG8_STAGE(PG8_SB(1, 0), cB + kstep, voffB); PG8_STAGE(PG8_SA(1, 0), cA + kstep, voffA); PG8_STAGE(PG8_SB(1, 1), cB + hstep + kstep, voffB);
        PG8_WAIT_V(6); PG8_BAR;
    }
    for (;;) {
        const bool has_next = S.next(ui + 1, nxt);
        const char* nA = has_next ? jobA(g, nxt.job) + (size_t)nxt.pm * tstep : cA; const char* nB = has_next ? jobB(g, nxt.job) + (size_t)nxt.pn * tstep : cB;
        for (int t = 0; t < nt; t += 2) {
            const bool last = (t == nt - 2);
            const char* a1 = cA + (size_t)(t + 1) * kstep;
            const char* a2 = last ? nA : cA + (size_t)(t + 2) * kstep; const char* b2 = last ? nB : cB + (size_t)(t + 2) * kstep;
            const char* a3 = a2 + kstep; const char* b3 = b2 + kstep;
            if (last && has_next) S.a_ready(nxt);
            if constexpr (SP2) {
            PG8_LDB(B0, 0, 0); PG8_LDB(B1, 0, 1); PG8_SCHED; PG8_LDA(At, 0, 0); PG8_STAGE(PG8_SA(1, 1), a1 + hstep, voffA);
            PG8_WAIT_V(8); PG8_WAIT_L(0); PG8_BAR; PG8_MMA(0, 0, At, B0); PG8_MMA(0, 1, At, B1); PG8_BAR; PG8_SCHED;
            PG8_LDA(At, 0, 1); PG8_STAGE(PG8_SB(0, 0), b2, voffB); PG8_STAGE(PG8_SB(0, 1), b2 + hstep, voffB); PG8_STAGE(PG8_SA(0, 0), a2, voffA);
            PG8_WAIT_V(8); PG8_WAIT_L(0); PG8_BAR; PG8_MMA(1, 0, At, B0); PG8_MMA(1, 1, At, B1); PG8_BAR; PG8_SCHED;
            PG8_LDB(B0, 1, 0); PG8_LDB(B1, 1, 1); PG8_SCHED; PG8_LDA(At, 1, 0); PG8_STAGE(PG8_SA(0, 1), a2 + hstep, voffA);
            PG8_WAIT_V(8); PG8_WAIT_L(0); PG8_BAR; PG8_MMA(0, 0, At, B0); PG8_MMA(0, 1, At, B1); PG8_BAR; PG8_SCHED;
            PG8_LDA(At, 1, 1); PG8_STAGE(PG8_SB(1, 0), b3, voffB); PG8_STAGE(PG8_SB(1, 1), b3 + hstep, voffB); PG8_STAGE(PG8_SA(1, 0), a3, voffA);
            PG8_WAIT_V(8); PG8_WAIT_L(0); PG8_BAR; PG8_MMA(1, 0, At, B0); PG8_MMA(1, 1, At, B1); PG8_BAR; PG8_SCHED;
            } else {
            PG8_LDB(B0, 0, 0); PG8_SCHED; PG8_LDA(At, 0, 0); PG8_STAGE(PG8_SA(1, 1), a1 + hstep, voffA);
            PG8_WAIT_L(8); PG8_BAR; PG8_WAIT_L(0); PG8_MMA(0, 0, At, B0); PG8_BAR; PG8_SCHED;
            PG8_LDB(B1, 0, 1); PG8_STAGE(PG8_SB(0, 0), b2, voffB);
            PG8_BAR; PG8_WAIT_L(0); PG8_MMA(0, 1, At, B1); PG8_BAR;
            PG8_LDA(At, 0, 1); PG8_STAGE(PG8_SA(0, 0), a2, voffA);
            PG8_BAR; PG8_WAIT_L(0); PG8_MMA(1, 0, At, B0); PG8_BAR; PG8_SCHED;
            PG8_STAGE(PG8_SB(0, 1), b2 + hstep, voffB);
            PG8_WAIT_V(6); PG8_BAR; PG8_MMA(1, 1, At, B1); PG8_BAR;
            PG8_LDB(B0, 1, 0); PG8_SCHED; PG8_LDA(At, 1, 0); PG8_STAGE(PG8_SA(0, 1), a2 + hstep, voffA);
            PG8_WAIT_L(8); PG8_BAR; PG8_WAIT_L(0); PG8_MMA(0, 0, At, B0); PG8_BAR; PG8_SCHED;
            PG8_LDB(B1, 1, 1); PG8_STAGE(PG8_SB(1, 0), b3, voffB);
            PG8_BAR; PG8_WAIT_L(0); PG8_MMA(0, 1, At, B1); PG8_BAR;
            PG8_LDA(At, 1, 1); PG8_STAGE(PG8_SA(1, 0), a3, voffA);
            PG8_BAR; PG8_WAIT_L(0); PG8_MMA(1, 0, At, B0); PG8_BAR; PG8_SCHED;
            PG8_STAGE(PG8_SB(1, 1), b3 + hstep, voffB);
            PG8_WAIT_V(6); PG8_BAR; PG8_MMA(1, 1, At, B1); PG8_BAR;
            }
        }
        if constexpr (ALIGN_EPI) { if (wr == 0) PG8_BAR; }
        if constexpr (!Epi::AFTER_DRAIN) { E(acc, cur, wr, wc, fr, fq); S.done(cur); }
        if (!has_next) break;
#pragma unroll
        for (int a = 0; a < 2; ++a)
#pragma unroll
            for (int b = 0; b < 2; ++b)
#pragma unroll
                for (int m = 0; m < 4; ++m)
#pragma unroll
                    for (int n = 0; n < 2; ++n) acc[a][b][m][n] = (f32x4){0.f, 0.f, 0.f, 0.f};
        cur = nxt; cA = nA; cB = nB; ++ui;
        if constexpr (ALIGN_EPI) { if (wr == 1) PG8_BAR; }
    }
    PG8_WAIT_V(0);
    if constexpr (!ALIGN_EPI) { if (wr == 0) PG8_BAR; }
    PG8_BAR;
    if constexpr (Epi::AFTER_DRAIN) { E.fused(acc, cur, wr, wc, fr, fq, lds, wid, lane); S.done(cur); }
#undef PG8_SA
#undef PG8_SB
#undef PG8_STAGE
#undef PG8_LDA
#undef PG8_LDB
#undef PG8_MMA
#undef PG8_WAIT_V
#undef PG8_WAIT_L
#undef PG8_BAR
#undef PG8_SCHED
}
}
#ifndef MIXSC
#define MIXSC 1.f
#endif
#ifndef BIASSC
#define BIASSC 1.f
#endif

constexpr int NWAVES = 8;
constexpr int N_LAUNCHES = MK_N_LAUNCHES;
constexpr int PER_PHASE = 10;
constexpr int BATCH = 16, SEQ = 2048, DM = 1024, MTOK = BATCH * SEQ, MEML = 256, MMEM = BATCH * MEML;
constexpr int NEXP = 16384;
constexpr float ALPHA = 1.189207115002721f;
constexpr float LN_EPS = 1e-5f;
constexpr float LAM_INIT = 0.2f;
constexpr float LOG2E = 1.4426950408889634f;

constexpr size_t MiB = 1u << 20;
constexpr size_t WS_CTL = 0, CTL_ZERO_BYTES = 1 * MiB;
constexpr size_t WS_W1T = 1 * MiB;
constexpr size_t WS_WVDT = 11 * MiB;
constexpr size_t WS_WGT = 13 * MiB;
constexpr size_t WS_WMKT = 19 * MiB;
constexpr size_t WS_WMVT = 21 * MiB;
constexpr size_t WS_WBT = 23 * MiB;
constexpr size_t WS_WOT = 29 * MiB;
constexpr size_t WS_WPQ = 31 * MiB;
constexpr size_t WS_SKD = 35 * MiB;
constexpr size_t WS_WST = 43 * MiB;
constexpr size_t WS_A0 = 48 * MiB, ACT_BYTES = 64 * MiB;
constexpr size_t WS_END = WS_A0 + 7 * ACT_BYTES;
constexpr size_t DO_XB = 0, DO_MEMB = 64 * MiB, DO_KM = 72 * MiB, DO_VMT = 80 * MiB;
constexpr int CW_TMO = 0, CW_CODE = 1, CW_BAR = 4096;

constexpr int RING_OFF = 0, RING_BYTES = 135168;
constexpr int LDSCTL_OFF = RING_BYTES, MISC_OFF = LDSCTL_OFF + 320;
constexpr int LDS_BYTES = 147456;
static_assert(MISC_OFF + 128 <= LDS_BYTES, "LDS map");

#define GAS __attribute__((address_space(1)))
#define LAS __attribute__((address_space(3)))
typedef unsigned short bf16;
typedef unsigned v4u __attribute__((ext_vector_type(4)));
typedef unsigned v2u __attribute__((ext_vector_type(2)));
typedef float f32x4 __attribute__((ext_vector_type(4)));
typedef float f32x16 __attribute__((ext_vector_type(16)));
typedef short bf16x8 __attribute__((ext_vector_type(8)));
typedef __bf16 bf16x2_t __attribute__((ext_vector_type(2)));
typedef float f32x2_t __attribute__((ext_vector_type(2)));
typedef GAS unsigned gu32;
#define RLX_AGENT __ATOMIC_RELAXED, __HIP_MEMORY_SCOPE_AGENT
#define LDS_WAIT() asm volatile("s_waitcnt lgkmcnt(0)" ::: "memory")
#define VM_WAIT() asm volatile("s_waitcnt vmcnt(0)" ::: "memory")
__device__ __forceinline__ unsigned f2bf(float f) { unsigned u = __builtin_bit_cast(unsigned, f); return (u + 0x7fffu + ((u >> 16) & 1u)) >> 16; }
__device__ __forceinline__ unsigned pk2(float lo, float hi) { f32x2_t v = {lo, hi}; bf16x2_t b = __builtin_convertvector(v, bf16x2_t); return __builtin_bit_cast(unsigned, b); }
__device__ __forceinline__ float bflo(unsigned w) { return __uint_as_float(w << 16); }
__device__ __forceinline__ float bfhi(unsigned w) { return __uint_as_float(w & 0xffff0000u); }
__device__ __forceinline__ float dot2_bf16(unsigned a, unsigned b, float acc) { return __builtin_amdgcn_fdot2_f32_bf16(__builtin_bit_cast(bf16x2_t, a), __builtin_bit_cast(bf16x2_t, b), acc, false); }
__device__ __forceinline__ float wave_sum(float v) {
#pragma unroll
    for (int o = 1; o < 64; o <<= 1) v += __shfl_xor(v, o);
    return v;
}
__device__ __forceinline__ float gelu1(float v) { pg8::f32x2 r = pg8::gelu_pk((pg8::f32x2){v, v}); return r.x; }

#define XB_TMO      128
#define XB_XCNT(j)  (256  + 64 * (j))
#define XB_XSUB(j)  (1280 + 64 * (j))
#define XB_XGEN(j)  (2304 + 64 * (j))
#define XB_TOP      3328
#define XB_TOPGEN   3392
#define XCD_BAR_WORDS 3456
#define XB_SPIN_CAP (1u << 22)

__device__ __forceinline__ unsigned xb_ld(unsigned* p)              { return __hip_atomic_load(p, __ATOMIC_RELAXED, __HIP_MEMORY_SCOPE_AGENT); }
__device__ __forceinline__ unsigned xb_add(unsigned* p, unsigned v) { return __hip_atomic_fetch_add(p, v, __ATOMIC_RELAXED, __HIP_MEMORY_SCOPE_AGENT); }
__device__ __forceinline__ unsigned xb_xcc_id() { return (unsigned)__builtin_amdgcn_s_getreg((3 << 11) | 20) & 0xFu; }
#define XB_SPIN(cond, bar) do { unsigned _sp = 0; while (cond) { __builtin_amdgcn_s_sleep(1); \
    if ((++_sp & 255u) == 0u) { if (xb_ld(&(bar)[XB_TMO])) break; if (_sp > XB_SPIN_CAP) { atomicAdd(&(bar)[XB_TMO], 1u); break; } } } } while (0)

struct XcdBarrier { unsigned* bar; unsigned x; volatile LAS unsigned* st; };

__device__ __forceinline__ XcdBarrier xcd_barrier_post(unsigned* bar, volatile LAS unsigned* st) {
    XcdBarrier b; b.bar = bar; b.x = xb_xcc_id(); b.st = st;
    if (threadIdx.x == 0) (void)xb_add(&bar[XB_XCNT(b.x)], 1u);
    return b;
}
__device__ __forceinline__ void xcd_barrier_complete(unsigned* bar, unsigned x, unsigned& nloc, unsigned& nx) {
    const unsigned G = gridDim.x * gridDim.y * gridDim.z;
    unsigned sum, cnt, mine, sp = 0u;
    for (;;) {
        sum = 0u; cnt = 0u; mine = 0u;
#pragma unroll
        for (unsigned j = 0; j < 16; ++j) { const unsigned c = xb_ld(&bar[XB_XCNT(j)]); sum += c; cnt += (c > 0u) ? 1u : 0u; mine = (j == x) ? c : mine; }
        if (sum == G) break;
        __builtin_amdgcn_s_sleep(1);
        if ((++sp & 255u) == 0u) { if (xb_ld(&bar[XB_TMO])) break; if (sp > XB_SPIN_CAP) { atomicAdd(&bar[XB_TMO], 1u); break; } }
    }
    nloc = mine > 0u ? mine : 1u; nx = cnt > 0u ? cnt : 1u;
}
__device__ __forceinline__ void xcd_barrier(const XcdBarrier& b) {
    asm volatile("s_waitcnt vmcnt(0)" ::: "memory");
    __syncthreads();
    if (threadIdx.x == 0) {
        unsigned* bar = b.bar;
        __builtin_amdgcn_s_waitcnt(0);
        unsigned nloc = b.st[0], nx = b.st[1];
        if (nloc == 0u) { xcd_barrier_complete(bar, b.x, nloc, nx); b.st[0] = nloc; b.st[1] = nx; }
        const unsigned old = xb_add(&bar[XB_XSUB(b.x)], 1u);
        const unsigned gen = old / nloc;
        if (old + 1u == (gen + 1u) * nloc) {
            __builtin_amdgcn_fence(__ATOMIC_RELEASE, "agent");
            asm volatile("s_waitcnt vmcnt(0)" ::: "memory");
            const unsigned og = xb_add(&bar[XB_TOP], 1u);
            const unsigned tg = og / nx;
            if (og + 1u == (tg + 1u) * nx) xb_add(&bar[XB_TOPGEN], 1u);
            else XB_SPIN(xb_ld(&bar[XB_TOPGEN]) == tg, bar);
            __builtin_amdgcn_fence(__ATOMIC_ACQUIRE, "agent");
            xb_add(&bar[XB_XGEN(b.x)], 1u);
            asm volatile("s_waitcnt vmcnt(0)" ::: "memory");
        } else {
            XB_SPIN(xb_ld(&bar[XB_XGEN(b.x)]) == gen, bar);
            __builtin_amdgcn_fence(__ATOMIC_ACQUIRE, "agent");
            asm volatile("s_waitcnt vmcnt(0)" ::: "memory");
        }
    }
    __syncthreads();
}

struct Args { const float* in[26]; float* out; unsigned char* ws; int ph_lo, ph_hi, li, pad; };
struct Frame {
    LAS unsigned char* lds;
    volatile LAS unsigned* MISC;
    gu32* ctl;
    int tid, lane, wave;
    int vcu, G;
    unsigned char* ws; unsigned char* dout;
};
__device__ __forceinline__ bf16* wsb(const Frame& F, size_t off) { return (bf16*)(F.ws + off); }
__device__ __forceinline__ bf16* act(const Frame& F, int i) { return (bf16*)(F.ws + WS_A0 + (size_t)i * ACT_BYTES); }

__device__ __forceinline__ void p0_transpose_item(const float* W, int ldw, int col_off, int ncols, int K, bf16* WT, int row_off, LAS float* scr, int item, int lane) {
    const int nblk = ncols / 32, kb = item / nblk, nb = item % nblk, k0 = 64 * kb, n0 = 32 * nb;
#pragma unroll 8
    for (int i = 0; i < 32; ++i) { const int kk = 2 * i + (lane >> 5); scr[kk * 33 + (lane & 31)] = W[(size_t)(k0 + kk) * ldw + col_off + n0 + (lane & 31)]; }
    LDS_WAIT(); asm volatile("" ::: "memory");
    const int c = lane & 7;
#pragma unroll
    for (int j = 0; j < 4; ++j) { const int n = (lane >> 3) + 8 * j; const LAS float* s = scr + (8 * c) * 33 + n;
        v4u o; o.x = pk2(s[0 * 33], s[1 * 33]); o.y = pk2(s[2 * 33], s[3 * 33]); o.z = pk2(s[4 * 33], s[5 * 33]); o.w = pk2(s[6 * 33], s[7 * 33]);
        *(GAS v4u*)(WT + (size_t)(row_off + n0 + n) * K + k0 + 8 * c) = o; }
    LDS_WAIT(); asm volatile("" ::: "memory");
}
__device__ __forceinline__ void cvt_row_1024(const float* src, bf16* dst, int lane) {
    const GAS f32x4* xr = (const GAS f32x4*)src + lane;
    GAS v2u* o8 = (GAS v2u*)dst + lane;
    f32x4 v[4];
#pragma unroll
    for (int j = 0; j < 4; ++j) v[j] = xr[64 * j];
#pragma unroll
    for (int j = 0; j < 4; ++j) { v2u w; w.x = pk2(v[j].x, v[j].y); w.y = pk2(v[j].z, v[j].w); o8[64 * j] = w; }
}
__device__ __forceinline__ void cvt_row_fp8(const float* src, unsigned char* dst, float* inv_out, int lane) {
    f32x4 v[4];
#pragma unroll
    for (int j = 0; j < 4; ++j) v[j] = *(const GAS f32x4*)(src + 16 * lane + 4 * j);
    float am = 0.f;
#pragma unroll
    for (int j = 0; j < 4; ++j) am = fmaxf(am, fmaxf(fmaxf(fabsf(v[j].x), fabsf(v[j].y)), fmaxf(fabsf(v[j].z), fabsf(v[j].w))));
#pragma unroll
    for (int o = 1; o < 64; o <<= 1) am = fmaxf(am, __shfl_xor(am, o));
    int E = (int)((__float_as_uint(am) >> 23) & 0xffu); E = E < 8 ? 8 : (E > 250 ? 250 : E);
    const float sc = __uint_as_float((unsigned)(260 - E) << 23), inv = __uint_as_float((unsigned)(E - 6) << 23);
    v4u o; unsigned w;
#pragma unroll
    for (int j = 0; j < 4; ++j) { w = (unsigned)__builtin_amdgcn_cvt_pk_fp8_f32(v[j].x * sc, v[j].y * sc, 0, false); w = (unsigned)__builtin_amdgcn_cvt_pk_fp8_f32(v[j].z * sc, v[j].w * sc, (int)w, true); o[j] = w; }
    *(GAS v4u*)(dst + 16 * lane) = o;
    if (lane == 0) *inv_out = inv;
}
__device__ __forceinline__ void p0_prologue(Frame& F, const Args& A) {
    LAS float* scr = (LAS float*)(F.lds + RING_OFF + F.wave * 16384);
    const int gw = F.vcu * NWAVES + F.wave, NGW = F.G * NWAVES;
    const float *w_in = A.in[2], *w_mkv = A.in[13], *w_gate = A.in[14], *w_br = A.in[16], *w_out = A.in[17];
    constexpr int I_IN0 = 16 * 128, I_INV = 16 * 32, I_INM = 16 * 32, I_G = 16 * 96, I_MK = 16 * 32, I_MV = 16 * 32, I_BR = 16 * 32, I_O = 16 * 32;
    constexpr int NT = I_IN0 + I_INV + I_INM + I_G + I_MK + I_MV + 3 * I_BR + I_O;
    for (int it = gw; it < NT; it += NGW) {
        int r = it;
        if (r < I_IN0) { p0_transpose_item(w_in, 6144, 0, 4096, 1024, wsb(F, WS_W1T), 0, scr, r, F.lane); continue; } r -= I_IN0;
        if (r < I_INV) { p0_transpose_item(w_in, 6144, 4096, 1024, 1024, wsb(F, WS_WVDT), 0, scr, r, F.lane); continue; } r -= I_INV;
        if (r < I_INM) { p0_transpose_item(w_in, 6144, 5120, 1024, 1024, wsb(F, WS_W1T), 4096, scr, r, F.lane); continue; } r -= I_INM;
        if (r < I_G) { p0_transpose_item(w_gate, 3072, 0, 3072, 1024, wsb(F, WS_WGT), 0, scr, r, F.lane); continue; } r -= I_G;
        if (r < I_MK) { p0_transpose_item(w_mkv, 2048, 0, 1024, 1024, wsb(F, WS_WMKT), 0, scr, r, F.lane); continue; } r -= I_MK;
        if (r < I_MV) { p0_transpose_item(w_mkv, 2048, 1024, 1024, 1024, wsb(F, WS_WMVT), 0, scr, r, F.lane); continue; } r -= I_MV;
        if (r < 3 * I_BR) { const int n = r / I_BR; p0_transpose_item(w_br + (size_t)n * 1024 * 1024, 1024, 0, 1024, 1024, wsb(F, WS_WBT) + (size_t)n * 1024 * 1024, 0, scr, r % I_BR, F.lane); continue; } r -= 3 * I_BR;
        p0_transpose_item(w_out, 1024, 0, 1024, 1024, wsb(F, WS_WOT), 0, scr, r, F.lane);
    }
    bf16* XB = (bf16*)(F.dout + DO_XB); bf16* MEMB = (bf16*)(F.dout + DO_MEMB);
    for (int m = gw; m < MTOK; m += NGW) cvt_row_1024(A.in[0] + (size_t)m * 1024, XB + (size_t)m * 1024, F.lane);
    for (int m = gw; m < MMEM; m += NGW) cvt_row_1024(A.in[1] + (size_t)m * 1024, MEMB + (size_t)m * 1024, F.lane);
    for (int m = gw; m < 2048; m += NGW) cvt_row_1024(A.in[20] + (size_t)m * 1024, wsb(F, WS_WPQ) + (size_t)m * 1024, F.lane);
    const float* sk = A.in[21];
    for (int r = gw; r < 2048; r += NGW) {
        const int cb = (r >> 7) << 7;
#pragma unroll
        for (int j = 0; j < 4; ++j) { const int c0 = 8 * (F.lane + 64 * j); v4u o = {0u, 0u, 0u, 0u};
            if (c0 >= cb && c0 < cb + 128) { const f32x4 a = *(const GAS f32x4*)(sk + (size_t)r * 128 + (c0 - cb)), b = *(const GAS f32x4*)(sk + (size_t)r * 128 + (c0 - cb) + 4);
                o.x = pk2(a.x, a.y); o.y = pk2(a.z, a.w); o.z = pk2(b.x, b.y); o.w = pk2(b.z, b.w); }
            *(GAS v4u*)(wsb(F, WS_SKD) + (size_t)r * 2048 + c0) = o; }
    }
}

#define MFMA32(a, b, c) __builtin_amdgcn_mfma_f32_32x32x16_bf16((a), (b), (c), 0, 0, 0)
__device__ __forceinline__ int crow(int r, int hi) { return (r & 3) + 8 * (r >> 2) + 4 * hi; }
__device__ __forceinline__ int swap23(int x) { return (x & ~12) | ((x & 4) << 1) | ((x & 8) >> 1); }
constexpr int P2_KBUF = 33792, P2_VBUF = 18432, P2_VROWB = 144;
constexpr int P2_K0 = 0, P2_V0 = 2 * P2_KBUF, P2_BT = P2_V0 + 2 * P2_VBUF, P2_SG = P2_BT + 512, P2_LAM = P2_SG + 512, P2_END = P2_LAM + 64;
static_assert(P2_END + 2 * 8192 <= RING_BYTES && 9216 + 3 * 8192 <= P2_KBUF, "P2 LDS");

template <int KSTEPS, bool BAND, bool QHOLD>
__device__ __forceinline__ void attn_pass(LAS unsigned char* lds, const bf16* qrow, const bf16* Kg, int kpitch, const bf16* Vg, int vpitch,
                                          int ntiles, int my_last, int band_first, int qpos, f32x16 (&O)[4], float& l_out) {
    constexpr int KROWB = KSTEPS * 32 + 16, KCH = KSTEPS * 2, KPT = (64 * KCH) / 512;
    static_assert(64 * KROWB <= P2_KBUF, "K tile");
    const int tid = threadIdx.x, lane = tid & 63, r = lane & 31, hi = lane >> 5;
    const LAS float* btab = (const LAS float*)(lds + P2_BT);
    v4u kreg[KPT], vreg[2];
    const bf16* ksrc[KPT]; int kdst[KPT]; const bf16* vsrc[2]; int vdst[2];
#pragma unroll
    for (int i = 0; i < KPT; ++i) { const int c = tid + 512 * i, row = c / KCH, part = c % KCH; ksrc[i] = Kg + (size_t)row * kpitch + part * 8; kdst[i] = ((row & 0x30) | swap23(row & 15)) * KROWB + part * 16; }
#pragma unroll
    for (int i = 0; i < 2; ++i) { const int c = tid + 512 * i, row = c >> 3, part = c & 7; vsrc[i] = Vg + (size_t)row * vpitch + part * 8; vdst[i] = row * P2_VROWB + part * 16; }
#pragma unroll
    for (int d = 0; d < 4; ++d) O[d] = f32x16{};
    float m_run = -1e30f, l_run = 0.f;
    bf16x8 qf[QHOLD ? KSTEPS : 1];
    if (QHOLD) {
#pragma unroll
        for (int ks = 0; ks < KSTEPS; ++ks) qf[QHOLD ? ks : 0] = *(const GAS bf16x8*)(qrow + ks * 16);
    }
#pragma unroll
    for (int i = 0; i < KPT; ++i) kreg[i] = *(const GAS v4u*)(ksrc[i]);
#pragma unroll
    for (int i = 0; i < 2; ++i) vreg[i] = *(const GAS v4u*)(vsrc[i]);
#pragma unroll
    for (int i = 0; i < KPT; ++i) *(LAS v4u*)(lds + P2_K0 + kdst[i]) = kreg[i];
#pragma unroll
    for (int i = 0; i < 2; ++i) *(LAS v4u*)(lds + P2_V0 + vdst[i]) = vreg[i];
    __syncthreads();
    for (int t = 0; t < ntiles; ++t) {
        const int cur = t & 1; const bool more = (t + 1 < ntiles);
        if (more) {
#pragma unroll
            for (int i = 0; i < KPT; ++i) kreg[i] = *(const GAS v4u*)(ksrc[i] + (size_t)(t + 1) * 64 * kpitch);
#pragma unroll
            for (int i = 0; i < 2; ++i) vreg[i] = *(const GAS v4u*)(vsrc[i] + (t + 1) * 64);
        }
        if (t <= my_last) {
            const LAS unsigned char* kb = lds + P2_K0 + cur * P2_KBUF + r * KROWB + hi * 16;
            const LAS unsigned char* vb = lds + P2_V0 + cur * P2_VBUF + r * P2_VROWB + hi * 16;
            f32x16 p0 = f32x16{}, p1 = f32x16{};
#pragma unroll
            for (int ks = 0; ks < KSTEPS; ++ks) {
                const bf16x8 a0 = *(const LAS bf16x8*)(kb + ks * 32), a1 = *(const LAS bf16x8*)(kb + 32 * KROWB + ks * 32);
                const bf16x8 qq = QHOLD ? qf[QHOLD ? ks : 0] : *(const GAS bf16x8*)(qrow + ks * 16);
                p0 = MFMA32(a0, qq, p0); p1 = MFMA32(a1, qq, p1);
            }
            if (BAND && t >= band_first) {
                const int kv0 = t * 64;
#pragma unroll
                for (int e = 0; e < 16; ++e) {
                    const int kl = swap23(crow(e, 0)) + 8 * hi;
                    const int rel0 = qpos - (kv0 + kl), rel1 = rel0 - 32;
                    const float b0 = btab[rel0 < 0 ? 0 : (rel0 > 127 ? 127 : rel0)], b1 = btab[rel1 < 0 ? 0 : (rel1 > 127 ? 127 : rel1)];
                    p0[e] = rel0 < 0 ? -1e30f : p0[e] + b0; p1[e] = rel1 < 0 ? -1e30f : p1[e] + b1;
                }
            }
            float mx = fmaxf(p0[0], p1[0]);
#pragma unroll
            for (int e = 1; e < 16; ++e) mx = fmaxf(mx, fmaxf(p0[e], p1[e]));
            mx = fmaxf(mx, __shfl_xor(mx, 32));
            const float m_new = fmaxf(m_run, mx), alpha = __builtin_amdgcn_exp2f(m_run - m_new);
            m_run = m_new;
            float ps = 0.f;
#pragma unroll
            for (int e = 0; e < 16; ++e) { p0[e] = __builtin_amdgcn_exp2f(p0[e] - m_new); p1[e] = __builtin_amdgcn_exp2f(p1[e] - m_new); ps += p0[e] + p1[e]; }
            l_run = l_run * alpha + ps;
#pragma unroll
            for (int d = 0; d < 4; ++d) O[d] = O[d] * alpha;
            bf16x8 pk[4];
#pragma unroll
            for (int s = 0; s < 2; ++s) {
                v4u w0, w1;
                w0.x = pk2(p0[8 * s + 0], p0[8 * s + 1]); w0.y = pk2(p0[8 * s + 2], p0[8 * s + 3]); w0.z = pk2(p0[8 * s + 4], p0[8 * s + 5]); w0.w = pk2(p0[8 * s + 6], p0[8 * s + 7]);
                w1.x = pk2(p1[8 * s + 0], p1[8 * s + 1]); w1.y = pk2(p1[8 * s + 2], p1[8 * s + 3]); w1.z = pk2(p1[8 * s + 4], p1[8 * s + 5]); w1.w = pk2(p1[8 * s + 6], p1[8 * s + 7]);
                pk[s] = __builtin_bit_cast(bf16x8, w0); pk[2 + s] = __builtin_bit_cast(bf16x8, w1);
            }
#pragma unroll
            for (int d = 0; d < 4; ++d)
#pragma unroll
                for (int s = 0; s < 4; ++s) { const bf16x8 a = *(const LAS bf16x8*)(vb + d * 32 * P2_VROWB + s * 32); O[d] = MFMA32(a, pk[s], O[d]); }
        }
        if (more) {
            const int nb = cur ^ 1;
#pragma unroll
            for (int i = 0; i < KPT; ++i) *(LAS v4u*)(lds + P2_K0 + nb * P2_KBUF + kdst[i]) = kreg[i];
#pragma unroll
            for (int i = 0; i < 2; ++i) *(LAS v4u*)(lds + P2_V0 + nb * P2_VBUF + vdst[i]) = vreg[i];
        }
        __syncthreads();
    }
    l_out = l_run + __shfl_xor(l_run, 32);
}

__device__ __forceinline__ void diff_unit(Frame& F, int b, int h, int qb, int dry) {
    const int lane = F.lane, r = lane & 31, hi = lane >> 5, wid = F.wave;
    const bf16 *QD = act(F, 2), *KD = act(F, 3), *VDT = act(F, 4); bf16* HB = dry ? act(F, 6) : act(F, 2);
    const int qw = qb * 256 + wid * 32, qpos = qw + r; const size_t row = (size_t)b * SEQ + qpos;
    const bf16* qrow = QD + row * 1024 + h * 128 + hi * 8;
    #ifdef ABL_NOSKIP
    const int ntiles = 4 * (qb + 1), my_last = ntiles - 1, band_first = 0;
#else
    const int ntiles = 4 * (qb + 1), my_last = (qw + 31) >> 6, band_first = (qw - 176) < 0 ? 0 : (qw - 176) >> 6;
#endif
    const bf16* Kb = KD + (size_t)b * SEQ * 1024 + h * 128; const bf16* Vb = VDT + (size_t)(h * 128) * MTOK + (size_t)b * SEQ;
    f32x16 O[4]; float l1, l2;
    attn_pass<4, true, false>(F.lds, qrow, Kb, 1024, Vb, MTOK, ntiles, my_last, band_first, qpos, O, l1);
    LAS unsigned* stash = (LAS unsigned*)(F.lds + (wid < 3 ? 9216 + wid * 8192 : wid < 6 ? P2_KBUF + 9216 + (wid - 3) * 8192 : P2_END + (wid - 6) * 8192));
    { const float inv = 1.0f / l1;
#pragma unroll
      for (int d = 0; d < 4; ++d)
#pragma unroll
          for (int e = 0; e < 8; ++e) stash[(d * 8 + e) * 64 + lane] = pk2(O[d][2 * e] * inv, O[d][2 * e + 1] * inv); }
    attn_pass<4, true, false>(F.lds, qrow + 64, Kb + 64, 1024, Vb, MTOK, ntiles, my_last, band_first, qpos, O, l2);
    const float lam = *(const LAS float*)(F.lds + P2_LAM), c2 = lam / l2;
    float ss = 0.f;
#pragma unroll
    for (int d = 0; d < 4; ++d)
#pragma unroll
        for (int e = 0; e < 8; ++e) { const unsigned o1 = stash[(d * 8 + e) * 64 + lane]; const float a = bflo(o1) - c2 * O[d][2 * e], c = bfhi(o1) - c2 * O[d][2 * e + 1]; O[d][2 * e] = a; O[d][2 * e + 1] = c; ss += a * a + c * c; }
    ss += __shfl_xor(ss, 32);
#ifdef ABL_QB
    const float rs = (qb == ABL_QB - 1) ? 0.f : __builtin_amdgcn_rsqf(ss * (1.0f / 128.0f) + LN_EPS) * (1.0f - LAM_INIT);
#else
    const float rs = __builtin_amdgcn_rsqf(ss * (1.0f / 128.0f) + LN_EPS) * (1.0f - LAM_INIT);
#endif
    const LAS float* sg = (const LAS float*)(F.lds + P2_SG);
#pragma unroll
    for (int d = 0; d < 4; ++d)
#pragma unroll
        for (int g = 0; g < 4; ++g) { const int dd = d * 32 + 8 * g + 4 * hi;
            v2u w; w.x = pk2(O[d][4 * g] * rs * sg[dd], O[d][4 * g + 1] * rs * sg[dd + 1]); w.y = pk2(O[d][4 * g + 2] * rs * sg[dd + 2], O[d][4 * g + 3] * rs * sg[dd + 3]);
            *(GAS v2u*)(HB + row * 1024 + h * 128 + dd) = w; }
    __syncthreads();
}
__device__ __forceinline__ void mem_unit(Frame& F, int b, int hm, int qb) {
    const int lane = F.lane, r = lane & 31, hi = lane >> 5, wid = F.wave;
    const bf16* QM = act(F, 5); bf16* HC = act(F, 6);
    const bf16* KM = (const bf16*)(F.dout + DO_KM); const bf16* VMT = (const bf16*)(F.dout + DO_VMT);
    const size_t row = (size_t)b * SEQ + qb * 256 + wid * 32 + r;
    const bf16* qrow = QM + row * 1024 + hm * 256 + hi * 8;
    const bf16* Kb = KM + (size_t)b * MEML * 1024 + hm * 256;
#pragma unroll 1
    for (int half = 0; half < 2; ++half) {
        const bf16* Vb = VMT + (size_t)(hm * 256 + half * 128) * MMEM + (size_t)b * MEML;
        f32x16 O[4]; float l;
        attn_pass<16, false, false>(F.lds, qrow, Kb, 1024, Vb, MMEM, 4, 3, 4, 0, O, l);
        const float inv = 1.0f / l;
#pragma unroll
        for (int d = 0; d < 4; ++d)
#pragma unroll
            for (int g = 0; g < 4; ++g) { const int dd = d * 32 + 8 * g + 4 * hi;
                v2u w; w.x = pk2(O[d][4 * g] * inv, O[d][4 * g + 1] * inv); w.y = pk2(O[d][4 * g + 2] * inv, O[d][4 * g + 3] * inv);
                *(GAS v2u*)(HC + row * 1024 + hm * 256 + half * 128 + dd) = w; }
    }
}
constexpr int SG_VNT = 0, SG_W = 34816, SG_ST = 69632, SG_ROWB = 272;
__device__ __forceinline__ void sgu_unit(Frame& F, const Args& A, int b, int chunk, int dry) {
    const int tid = F.tid, lane = F.lane, r = lane & 31, hi = lane >> 5, wid = F.wave;
    bf16* U = act(F, 0); const bf16* V = act(F, 1); bf16* HAo = dry ? act(F, 6) : act(F, 0);
    const size_t t0 = (size_t)b * SEQ + chunk * 128;
    const float *lng = A.in[3], *lnb = A.in[4], *wsp = A.in[5], *bsp = A.in[6];
    LAS float* st = (LAS float*)(F.lds + SG_ST);
#pragma unroll 1
    for (int i = 0; i < 16; ++i) { const int s = wid * 16 + i; const bf16* vr = V + (t0 + s) * 1024;
        const v4u a = *(const GAS v4u*)(vr + lane * 8), c = *(const GAS v4u*)(vr + 512 + lane * 8);
        float x[16] = {bflo(a.x), bfhi(a.x), bflo(a.y), bfhi(a.y), bflo(a.z), bfhi(a.z), bflo(a.w), bfhi(a.w), bflo(c.x), bfhi(c.x), bflo(c.y), bfhi(c.y), bflo(c.z), bfhi(c.z), bflo(c.w), bfhi(c.w)};
        float sm = 0.f;
#pragma unroll
        for (int j = 0; j < 16; ++j) sm += x[j];
        const float mean = wave_sum(sm) * (1.0f / 1024.0f); float sq = 0.f;
#pragma unroll
        for (int j = 0; j < 16; ++j) { const float d = x[j] - mean; sq += d * d; }
        const float rstd = __builtin_amdgcn_rsqf(wave_sum(sq) * (1.0f / 1024.0f) + LN_EPS);
        if (lane == 0) { st[2 * s] = mean; st[2 * s + 1] = rstd; } }
    __syncthreads();
#pragma unroll 1
    for (int g = 0; g < 8; ++g) {
#pragma unroll
        for (int i = 0; i < 4; ++i) { const int c = tid + 512 * i, s = c >> 4, part = c & 15; const int ch = g * 128 + part * 8;
            const v4u a = *(const GAS v4u*)(V + (t0 + s) * 1024 + ch); const float mean = st[2 * s], rstd = st[2 * s + 1];
            const f32x4 g0 = *(const GAS f32x4*)(lng + ch), g1 = *(const GAS f32x4*)(lng + ch + 4), b0 = *(const GAS f32x4*)(lnb + ch), b1 = *(const GAS f32x4*)(lnb + ch + 4);
            const float x[8] = {bflo(a.x), bfhi(a.x), bflo(a.y), bfhi(a.y), bflo(a.z), bfhi(a.z), bflo(a.w), bfhi(a.w)};
            const float gg[8] = {g0.x, g0.y, g0.z, g0.w, g1.x, g1.y, g1.z, g1.w}, bb[8] = {b0.x, b0.y, b0.z, b0.w, b1.x, b1.y, b1.z, b1.w};
#pragma unroll
            for (int e = 0; e < 8; ++e) *(LAS unsigned short*)(F.lds + SG_VNT + (part * 8 + e) * SG_ROWB + s * 2) = (unsigned short)f2bf((x[e] - mean) * rstd * gg[e] + bb[e]); }
#pragma unroll
        for (int i = 0; i < 8; ++i) { const int c = tid + 512 * i, t = c >> 5, part = c & 31, s0 = part * 4;
            const f32x4 w = *(const GAS f32x4*)(wsp + ((size_t)g * 128 + t) * 128 + s0);
            v2u o; o.x = pk2(s0 <= t ? w.x : 0.f, s0 + 1 <= t ? w.y : 0.f); o.y = pk2(s0 + 2 <= t ? w.z : 0.f, s0 + 3 <= t ? w.w : 0.f);
            *(LAS v2u*)(F.lds + SG_W + t * SG_ROWB + part * 8) = o; }
        __syncthreads();
        const int dblk = wid >> 1;
        f32x16 acc[2] = {f32x16{}, f32x16{}};
#pragma unroll
        for (int j = 0; j < 2; ++j) { const int tblk = 2 * (wid & 1) + j;
#pragma unroll
#ifdef ABL_NOSKIP
            for (int ks = 0; ks < 8; ++ks) {
#else
            for (int ks = 0; ks < 8; ++ks) if (ks <= 2 * tblk + 1) {
#endif
                const bf16x8 a = *(const LAS bf16x8*)(F.lds + SG_VNT + (dblk * 32 + r) * SG_ROWB + ks * 32 + hi * 16);
                const bf16x8 bq = *(const LAS bf16x8*)(F.lds + SG_W + (tblk * 32 + r) * SG_ROWB + ks * 32 + hi * 16);
                acc[j] = MFMA32(a, bq, acc[j]); } }
#pragma unroll
        for (int j = 0; j < 2; ++j) { const int t = (2 * (wid & 1) + j) * 32 + r; const float bs = bsp[g * 128 + t] * BIASSC; bf16* up = U + (t0 + t) * 1024 + g * 128 + dblk * 32 + 4 * hi;
#pragma unroll
            for (int q = 0; q < 4; ++q) { const v2u uu = *(const GAS v2u*)(up + 8 * q);
                v2u o; o.x = pk2(bflo(uu.x) * (acc[j][4 * q] * MIXSC + bs), bfhi(uu.x) * (acc[j][4 * q + 1] * MIXSC + bs)); o.y = pk2(bflo(uu.y) * (acc[j][4 * q + 2] * MIXSC + bs), bfhi(uu.y) * (acc[j][4 * q + 3] * MIXSC + bs));
                *(GAS v2u*)(HAo + (up - U) + 8 * q) = o; } }
        __syncthreads();
    }
}
__device__ __forceinline__ int t5_bucket(int n) {
    if (n < 16) return n;
    int l = 16 + (int)(logf((float)n / 16.0f) / 2.0794415416798357f * 16.0f);
    return l < 31 ? l : 31;
}
__device__ __forceinline__ void p2_phase(Frame& F, const Args& A, int dry) {
    {
        LAS float* bt = (LAS float*)(F.lds + P2_BT); LAS float* sg = (LAS float*)(F.lds + P2_SG); LAS float* lm = (LAS float*)(F.lds + P2_LAM);
        if (F.tid < 128) sg[F.tid] = A.in[11][F.tid];
        if (F.wave == 2) { const float a = wave_sum(A.in[7][F.lane] * A.in[8][F.lane]), c = wave_sum(A.in[9][F.lane] * A.in[10][F.lane]); if (F.lane == 0) lm[0] = expf(a) - expf(c) + LAM_INIT; }
    }
    __syncthreads();
    for (int v = F.vcu; v < 256; v += F.G) {
        const int x = v >> 5, w = v & 31;
#pragma unroll 1
        for (int rd = 0; rd < 4; ++rd) {
            const int bh = 16 * x + 4 * rd + (w >> 3), qb = (rd & 1) ? 7 - (w & 7) : (w & 7), b = bh >> 3, h = bh & 7;
            { LAS float* bt = (LAS float*)(F.lds + P2_BT); const float* tab = A.in[12];
              if (F.tid < 128) bt[F.tid] = (tab[t5_bucket(F.tid) * 8 + h] - tab[31 * 8 + h]) * LOG2E; }
            __syncthreads();
#ifndef NO_DIFF
            diff_unit(F, b, h, qb, dry);
#endif
        }
    }
    for (int v = F.vcu; v < 256; v += F.G) {
#pragma unroll 1
        for (int i = 0; i < 2; ++i) { const int id = 2 * v + i;
#ifndef NO_MEM
            mem_unit(F, id >> 5, (id >> 3) & 3, id & 7);
#endif
        }
    }
#ifndef NO_SGU
    for (int v = F.vcu; v < 256; v += F.G) sgu_unit(F, A, v >> 4, v & 15, dry);
#endif
}

__device__ __forceinline__ void ln1_rows(Frame& F, const Args& A) {
    const int gw = F.vcu * NWAVES + F.wave, NGW = F.G * NWAVES;
    float* R = (float*)F.dout; bf16* X1B = act(F, 0); const float *g = A.in[18], *bb = A.in[19];
    f32x4 gv[4], bv[4];
#pragma unroll
    for (int j = 0; j < 4; ++j) { gv[j] = *(const GAS f32x4*)(g + 4 * F.lane + 256 * j); bv[j] = *(const GAS f32x4*)(bb + 4 * F.lane + 256 * j); }
    for (int m = gw; m < MTOK; m += NGW) {
        GAS f32x4* xr = (GAS f32x4*)(R + (size_t)m * 1024) + F.lane;
        f32x4 v[4]; float s = 0.f;
#pragma unroll
        for (int j = 0; j < 4; ++j) { v[j] = xr[64 * j]; s += (v[j].x + v[j].y) + (v[j].z + v[j].w); }
        const float mean = wave_sum(s) * (1.f / 1024.f); float s2 = 0.f;
#pragma unroll
        for (int j = 0; j < 4; ++j) { v[j] = v[j] - mean; s2 += (v[j].x * v[j].x + v[j].y * v[j].y) + (v[j].z * v[j].z + v[j].w * v[j].w); }
        const float rstd = __builtin_amdgcn_rsqf(wave_sum(s2) * (1.f / 1024.f) + LN_EPS);
        GAS v2u* o8 = (GAS v2u*)(X1B + (size_t)m * 1024) + F.lane;
#pragma unroll
        for (int j = 0; j < 4; ++j) { const f32x4 y = v[j] * rstd * gv[j] + bv[j]; xr[64 * j] = y; v2u w; w.x = pk2(y.x, y.y); w.y = pk2(y.z, y.w); o8[64 * j] = w; }
    }
}

constexpr int TK_ROWB = 528;
#define MED3(a, b, c) __builtin_amdgcn_fmed3f((a), (b), (c))
__device__ __forceinline__ void topk_phase(Frame& F) {
    const int lane = F.lane, p = lane & 31, half = lane >> 5;
    const int gw = F.vcu * NWAVES + F.wave, NGW = F.G * NWAVES;
    LAS unsigned char* tile = F.lds + RING_OFF + F.wave * (32 * TK_ROWB);
    int* IDX = (int*)(F.ws + WS_A0 + 3 * ACT_BYTES); float* GATE = (float*)(F.ws + WS_A0 + 3 * ACT_BYTES + 16 * MiB);
    for (int it = gw; it < (MTOK / 32) * 8; it += NGW) {
        const int h = it & 7, t0 = (it >> 3) * 32;
        const bf16* S = act(F, h < 4 ? 2 : 5) + (size_t)t0 * 1024 + (h & 3) * 256;
#pragma unroll
        for (int i = 0; i < 16; ++i) { const int row = 2 * i + half; const v4u v = *(const GAS v4u*)(S + (size_t)row * 1024 + p * 8); *(LAS v4u*)(tile + row * TK_ROWB + p * 16) = v; }
        LDS_WAIT(); asm volatile("" ::: "memory");
        float L[16];
#pragma unroll
        for (int i = 0; i < 16; ++i) L[i] = -INFINITY;
        const LAS unsigned char* myrow = tile + p * TK_ROWB + half * 256;
#pragma unroll 2
        for (int j = 0; j < 16; ++j) {
            const v4u w = *(const LAS v4u*)(myrow + j * 16);
            const unsigned ww[4] = {w.x, w.y, w.z, w.w};
#pragma unroll
            for (int e = 0; e < 8; ++e) {
                const unsigned bits = ((e & 1) ? (ww[e >> 1] & 0xffff0000u) : (ww[e >> 1] << 16)) | (unsigned)(j * 8 + e);
                const float v = __uint_as_float(bits);
#pragma unroll
                for (int i = 15; i >= 1; --i) L[i] = MED3(L[i - 1], L[i], v);
                L[0] = fmaxf(L[0], v);
            }
        }
        float A[16], Bv[16];
#pragma unroll
        for (int i = 0; i < 16; ++i) { const float o = __shfl_xor(L[i], 32); A[i] = half ? o : L[i]; Bv[i] = half ? L[i] : o; }
        LAS unsigned* mine = (LAS unsigned*)(tile + p * TK_ROWB + half * 256);
        asm volatile("" ::: "memory");
#pragma unroll
        for (int i = 0; i < 16; ++i) { mine[i] = __float_as_uint(A[i]) & 0x7fu; mine[16 + i] = __float_as_uint(Bv[i]) & 0x7fu; }
        float T[16];
#pragma unroll
        for (int i = 0; i < 16; ++i) T[i] = -INFINITY;
#pragma unroll
        for (int i = 0; i < 16; ++i)
#pragma unroll
            for (int j = 0; j < 16; ++j) if ((i + 1) * (j + 1) <= 16) {
                const float sum = __uint_as_float(__float_as_uint(A[i]) & 0xffff0000u) + __uint_as_float(__float_as_uint(Bv[j]) & 0xffff0000u);
                const float v = __uint_as_float((__float_as_uint(sum) & 0xffffff00u) | (unsigned)(i * 16 + j));
#pragma unroll
                for (int q = 15; q >= 1; --q) T[q] = MED3(T[q - 1], T[q], v);
                T[0] = fmaxf(T[0], v);
            }
        float e[16], den = 0.f; const float mxs = __uint_as_float(__float_as_uint(T[0]) & 0xffffff00u);
#pragma unroll
        for (int q = 0; q < 16; ++q) { e[q] = __expf(__uint_as_float(__float_as_uint(T[q]) & 0xffffff00u) - mxs); den += e[q]; }
        const float inv = 1.0f / den;
        LDS_WAIT(); asm volatile("" ::: "memory");
        int id8[8]; float g8[8];
#pragma unroll
        for (int q = 0; q < 8; ++q) {
            const float tv = half ? T[8 + q] : T[q]; const unsigned code = __float_as_uint(tv) & 0xffu;
            id8[q] = (int)(mine[code >> 4] * 128u + mine[16 + (code & 15u)]); g8[q] = (half ? e[8 + q] : e[q]) * inv;
        }
        const size_t o = (size_t)(t0 + p) * 128 + h * 16 + half * 8;
        *(GAS v4u*)(IDX + o) = (v4u){(unsigned)id8[0], (unsigned)id8[1], (unsigned)id8[2], (unsigned)id8[3]}; *(GAS v4u*)(IDX + o + 4) = (v4u){(unsigned)id8[4], (unsigned)id8[5], (unsigned)id8[6], (unsigned)id8[7]};
        *(GAS f32x4*)(GATE + o) = (f32x4){g8[0], g8[1], g8[2], g8[3]}; *(GAS f32x4*)(GATE + o + 4) = (f32x4){g8[4], g8[5], g8[6], g8[7]};
        LDS_WAIT(); asm volatile("" ::: "memory");
    }
}

__device__ __forceinline__ void fp8x16_to_f32(const v4u& a, float (&f)[16]) {
#pragma unroll
    for (int j = 0; j < 4; ++j) { const f32x2_t lo = __builtin_amdgcn_cvt_pk_f32_fp8((int)a[j], false), hi = __builtin_amdgcn_cvt_pk_f32_fp8((int)a[j], true);
        f[4 * j] = lo.x; f[4 * j + 1] = lo.y; f[4 * j + 2] = hi.x; f[4 * j + 3] = hi.y; }
}
__device__ __forceinline__ void peer_phase(Frame& F, const Args& A, int dry) {
    const int lane = F.lane;
    const int gw = F.vcu * NWAVES + F.wave, NGW = F.G * NWAVES;
    const int* IDX = (const int*)(F.ws + WS_A0 + 3 * ACT_BYTES); const float* GATE = (const float*)(F.ws + WS_A0 + 3 * ACT_BYTES + 16 * MiB);
    const unsigned char* PU8 = (const unsigned char*)act(F, 1); const unsigned char* PV8 = PU8 + 16 * MiB; const float* PUS = (const float*)(PU8 + 32 * MiB); const float* PVS = PUS + NEXP;
    float* X1 = (float*)F.dout; const float *g2 = A.in[24], *b2 = A.in[25];
    for (int m = gw; m < MTOK; m += NGW) {
        const int id0 = IDX[(size_t)m * 128 + lane], id1 = IDX[(size_t)m * 128 + 64 + lane];
        const float ga0 = GATE[(size_t)m * 128 + lane], ga1 = GATE[(size_t)m * 128 + 64 + lane];
        const float su0 = PUS[id0], su1 = PUS[id1], sv0 = PVS[id0], sv1 = PVS[id1];
        float* xr = X1 + (size_t)m * 1024 + 16 * lane;
        float x[16];
#pragma unroll
        for (int j = 0; j < 4; ++j) { const f32x4 t = *(const GAS f32x4*)(xr + 4 * j); x[4 * j] = t.x; x[4 * j + 1] = t.y; x[4 * j + 2] = t.z; x[4 * j + 3] = t.w; }
#define PEER_LOADG(buf, tab, idv, l0) do { _Pragma("unroll") for (int e_ = 0; e_ < 8; ++e_) { const int row_ = __builtin_amdgcn_readlane((idv), (l0) + e_); buf[e_] = *(const GAS v4u*)((tab) + (size_t)row_ * 1024 + 16 * lane); } } while (0)
#define PEER_DOTG(buf, o0) do { _Pragma("unroll") for (int e_ = 0; e_ < 8; ++e_) { float f_[16]; fp8x16_to_f32(buf[e_], f_); \
            float s0_ = x[0] * f_[0], s1_ = x[1] * f_[1], s2_ = x[2] * f_[2], s3_ = x[3] * f_[3]; \
            _Pragma("unroll") for (int j_ = 1; j_ < 4; ++j_) { s0_ += x[4 * j_] * f_[4 * j_]; s1_ += x[4 * j_ + 1] * f_[4 * j_ + 1]; s2_ += x[4 * j_ + 2] * f_[4 * j_ + 2]; s3_ += x[4 * j_ + 3] * f_[4 * j_ + 3]; } \
            pr[(o0) + e_] = (s0_ + s1_) + (s2_ + s3_); } __builtin_amdgcn_sched_barrier(0); } while (0)
#define PEER_AXPYG(buf, wv_, l0) do { _Pragma("unroll") for (int e_ = 0; e_ < 8; ++e_) { const float w_ = __builtin_bit_cast(float, __builtin_amdgcn_readlane(__builtin_bit_cast(int, (wv_)), (l0) + e_)); \
            float f_[16]; fp8x16_to_f32(buf[e_], f_); _Pragma("unroll") for (int j_ = 0; j_ < 16; ++j_) y[j_] += w_ * f_[j_]; } __builtin_amdgcn_sched_barrier(0); } while (0)
        v4u b0[8], b1[8];
        float d01 = 0.f, d23 = 0.f;
        PEER_LOADG(b0, PU8, id0, 0);
#pragma unroll 1
        for (int blk = 0; blk < 4; ++blk) {
            const int idv = blk < 2 ? id0 : id1, l0 = (blk & 1) * 32;
            float pr[32];
            PEER_LOADG(b1, PU8, idv, l0 + 8);  __builtin_amdgcn_sched_barrier(0);
            PEER_DOTG(b0, 0);
            PEER_LOADG(b0, PU8, idv, l0 + 16); __builtin_amdgcn_sched_barrier(0);
            PEER_DOTG(b1, 8);
            PEER_LOADG(b1, PU8, idv, l0 + 24); __builtin_amdgcn_sched_barrier(0);
            PEER_DOTG(b0, 16);
            if (blk < 3) { const int idn = blk < 1 ? id0 : id1, ln = ((blk + 1) & 1) * 32; PEER_LOADG(b0, PU8, idn, ln); }
            else PEER_LOADG(b0, PV8, id0, 0);
            __builtin_amdgcn_sched_barrier(0);
            PEER_DOTG(b1, 24);
#pragma unroll
            for (int s = 16; s >= 1; s >>= 1) {
                const bool up = (lane & s) != 0;
#pragma unroll
                for (int i = 0; i < s; ++i) { const float lo = pr[i], hv = pr[i + s]; const float send = up ? lo : hv, keep = up ? hv : lo; pr[i] = keep + __shfl_xor(send, s); }
            }
            const float d = pr[0] + __shfl_xor(pr[0], 32); const bool mine = (lane >> 5) == (blk & 1);
            if (blk < 2) d01 = mine ? d : d01; else d23 = mine ? d : d23;
        }
        const float wg0 = ga0 * gelu1(d01 * su0) * sv0;
        const float wg1 = ga1 * gelu1(d23 * su1) * sv1;
        float y[16];
#pragma unroll
        for (int j = 0; j < 16; ++j) y[j] = 0.f;
#pragma unroll 1
        for (int gg = 0; gg < 8; ++gg) {
            const int ida = gg < 4 ? id0 : id1; const float wa = gg < 4 ? wg0 : wg1; const int la = (gg & 3) * 16;
            PEER_LOADG(b1, PV8, ida, la + 8); __builtin_amdgcn_sched_barrier(0);
            PEER_AXPYG(b0, wa, la);
            if (gg < 7) { const int idb = gg < 3 ? id0 : id1, lb = ((gg + 1) & 3) * 16; PEER_LOADG(b0, PV8, idb, lb); }
            __builtin_amdgcn_sched_barrier(0);
            PEER_AXPYG(b1, wa, la + 8);
        }
#undef PEER_LOADG
#undef PEER_DOTG
#undef PEER_AXPYG
        f32x4 v[4]; float s = 0.f;
#pragma unroll
        for (int j = 0; j < 4; ++j) { v[j] = (f32x4){x[4 * j], x[4 * j + 1], x[4 * j + 2], x[4 * j + 3]} * ALPHA + (f32x4){y[4 * j], y[4 * j + 1], y[4 * j + 2], y[4 * j + 3]} * (ABL_PEER == 1 ? 0.f : ABL_PEER == 2 ? 0.5f : ABL_PEER == 3 ? 2.f : 1.f); s += (v[j].x + v[j].y) + (v[j].z + v[j].w); }
        const float mean = wave_sum(s) * (1.f / 1024.f); float s2 = 0.f;
#pragma unroll
        for (int j = 0; j < 4; ++j) { v[j] = v[j] - mean; s2 += (v[j].x * v[j].x + v[j].y * v[j].y) + (v[j].z * v[j].z + v[j].w * v[j].w); }
        const float rstd = __builtin_amdgcn_rsqf(wave_sum(s2) * (1.f / 1024.f) + LN_EPS);
        float* orow = (dry ? (float*)act(F, 5) + (size_t)m * 1024 : X1 + (size_t)m * 1024) + 16 * lane;
#pragma unroll
        for (int j = 0; j < 4; ++j) { const f32x4 gg = *(const GAS f32x4*)(g2 + 16 * lane + 4 * j), bb = *(const GAS f32x4*)(b2 + 16 * lane + 4 * j);
            *(GAS f32x4*)(orow + 4 * j) = v[j] * rstd * gg + bb; }
    }
}

__global__ void __launch_bounds__(NWAVES * 64, 2) mk_fwd(Args A) {
    extern __shared__ __attribute__((aligned(16))) unsigned char lds[];
    Frame F;
    F.lds = (LAS unsigned char*)lds;
    F.MISC = (volatile LAS unsigned*)(F.lds + MISC_OFF);
    F.tid = threadIdx.x; F.lane = F.tid & 63; F.wave = __builtin_amdgcn_readfirstlane(F.tid >> 6);
    F.G = gridDim.x; { const int bx = blockIdx.x; F.vcu = (F.G % 8 == 0) ? (bx % 8) * (F.G / 8) + bx / 8 : bx; }
    F.ws = A.ws; F.dout = (unsigned char*)A.out; F.ctl = (gu32*)(A.ws + WS_CTL);
    for (int u = F.tid; u < (LDS_BYTES - LDSCTL_OFF) / 4; u += NWAVES * 64) ((LAS unsigned*)(F.lds + LDSCTL_OFF))[u] = 0u;
    __syncthreads();
    XcdBarrier bar; bar.bar = (unsigned*)(F.ctl + CW_BAR); bar.x = 0; bar.st = nullptr;
    if (N_LAUNCHES != PER_PHASE) bar = xcd_barrier_post((unsigned*)(F.ctl + CW_BAR), F.MISC + 8);
#define GRID_BAR() do { if (N_LAUNCHES != PER_PHASE) xcd_barrier(bar); } while (0)
#ifdef TSTAMP
    unsigned long long* tsb = (unsigned long long*)(A.ws + 131072); int nst = 0;
#define STAMP() do { if (blockIdx.x == 0 && F.tid == 0) tsb[nst] = __builtin_amdgcn_s_memrealtime(); ++nst; } while (0)
    STAMP();
#else
#define STAMP() do {} while (0)
#endif
#ifndef REPEAT_PH
#define REPEAT_PH -1
#endif

    const int lo = A.ph_lo, hi = A.ph_hi;
#ifndef MK_PHASE_MASK
#define MK_PHASE_MASK 0x3ff
#endif
#define IN(k) (((MK_PHASE_MASK >> (k)) & 1) && lo <= (k) && (k) < hi)
#define BOTH(k) (IN(k) && IN((k) + 1))
    const bf16* XB = (const bf16*)(F.dout + DO_XB);

    if (IN(0)) { p0_prologue(F, A); if (BOTH(0)) GRID_BAR(); STAMP(); }

    if (IN(1)) {
        { pg8::Gemm g{XB, wsb(F, WS_WVDT), (const bf16*)(F.dout + DO_MEMB), wsb(F, WS_WMVT), wsb(F, WS_W1T), XB, wsb(F, WS_WMKT), (const bf16*)(F.dout + DO_MEMB), 1024};
          pg8::MultiOrder S; S.init(F.G, (int)blockIdx.x, 128, 20, 4, 128, 16, 4, 4, 16);
          pg8::EpiP1 E{act(F, 0), act(F, 1), act(F, 2), act(F, 3), act(F, 5), act(F, 4), (bf16*)(F.dout + DO_KM), (bf16*)(F.dout + DO_VMT)};
          pg8::gemm_phase<pg8::EpiP1, pg8::MultiOrder, true, true>(F.lds + RING_OFF, g, S, E); }
        { pg8::Gemm g{wsb(F, WS_SKD), nullptr, nullptr, nullptr, wsb(F, WS_WPQ), nullptr, nullptr, nullptr, 2048};
          pg8::MultiOrder S; S.init(F.G, (int)blockIdx.x, 8, 4);
          pg8::EpiPlain E{wsb(F, WS_WST), 1024};
          pg8::gemm_phase<pg8::EpiPlain, pg8::MultiOrder, true, true>(F.lds + RING_OFF, g, S, E); }
        if (BOTH(1)) GRID_BAR(); STAMP();
    }

    if (IN(2)) { p2_phase(F, A, A.pad); if (BOTH(2)) GRID_BAR(); STAMP(); }

    if (IN(3)) {
        pg8::Gemm g{XB, nullptr, nullptr, nullptr, wsb(F, WS_WGT), nullptr, nullptr, nullptr, 1024};
        pg8::MultiOrder S; S.init(F.G, (int)blockIdx.x, 128, 12);
#ifdef SWAPG
        pg8::EpiSplit<3> E{act(F, 3), act(F, 1), act(F, 4), A.in[15]};
#else
        pg8::EpiSplit<3> E{act(F, 1), act(F, 3), act(F, 4), A.in[15]};
#endif
        pg8::gemm_phase<pg8::EpiSplit<3>, pg8::MultiOrder, true, true>(F.lds + RING_OFF, g, S, E);
        if (BOTH(3)) GRID_BAR(); STAMP();
    }

    if (IN(4)) {
        pg8::Gemm g{act(F, 0), act(F, 2), act(F, 6), nullptr, wsb(F, WS_WBT), wsb(F, WS_WBT) + (size_t)1024 * 1024, wsb(F, WS_WBT) + (size_t)2 * 1024 * 1024, nullptr, 1024};
        pg8::MultiOrder S; S.init(F.G, (int)blockIdx.x, 128, 4, 128, 4, 128, 4);
        pg8::EpiMerge E{act(F, 5), act(F, 1), act(F, 3), act(F, 4)};
        pg8::gemm_phase<pg8::EpiMerge, pg8::MultiOrder, true, true>(F.lds + RING_OFF, g, S, E);
        if (BOTH(4)) GRID_BAR(); STAMP();
    }

    if (IN(5)) {
        pg8::Gemm g{act(F, 5), nullptr, nullptr, nullptr, wsb(F, WS_WOT), nullptr, nullptr, nullptr, 1024};
        pg8::MultiOrder S; S.init(F.G, (int)blockIdx.x, 128, 4);
        pg8::EpiResid E{A.in[0], (float*)F.dout, ALPHA};
        pg8::gemm_phase<pg8::EpiResid, pg8::MultiOrder, true, true>(F.lds + RING_OFF, g, S, E);
        const int gw = F.vcu * NWAVES + F.wave, NGW = F.G * NWAVES;
        unsigned char* P8 = (unsigned char*)act(F, 1); float* PS = (float*)(P8 + 32 * MiB);
        for (int m = gw; m < 2 * NEXP; m += NGW) cvt_row_fp8((m < NEXP ? A.in[22] : A.in[23] - (size_t)NEXP * 1024) + (size_t)m * 1024, P8 + (size_t)m * 1024, PS + m, F.lane);
        if (BOTH(5)) GRID_BAR(); STAMP();
    }

    if (IN(6)) { ln1_rows(F, A); if (BOTH(6)) GRID_BAR(); STAMP(); }

    if (IN(7)) {
        pg8::Gemm g{act(F, 0), nullptr, nullptr, nullptr, wsb(F, WS_WST), nullptr, nullptr, nullptr, 1024};
        pg8::MultiOrder S; S.init(F.G, (int)blockIdx.x, 128, 8);
        pg8::EpiSplit<0> E{act(F, 2), act(F, 5), act(F, 5), A.in[15]};
        pg8::gemm_phase<pg8::EpiSplit<0>, pg8::MultiOrder, true, true>(F.lds + RING_OFF, g, S, E);
        if (BOTH(7)) GRID_BAR(); STAMP();
    }

    if (IN(8)) { topk_phase(F); if (BOTH(8)) GRID_BAR(); STAMP(); }

    if (IN(9)) { peer_phase(F, A, A.pad); STAMP(); }
#undef IN
#undef BOTH
}


#ifdef TSTAMP
__global__ void __launch_bounds__(256) ts_encode(float* out, const unsigned long long* ts, int k) {
    const float us = (float)(ts[k + 1] - ts[k]) * 0.01f; const float C = sqrtf(us);
    for (size_t i = (size_t)blockIdx.x * blockDim.x + threadIdx.x; i < (size_t)MTOK * DM; i += (size_t)gridDim.x * blockDim.x) out[i] = C;
}
#endif
extern "C" void kernel_launch(void* const* d_in, const int* in_sizes, int n_in, void* d_out, int out_size, void* d_ws, size_t ws_size, hipStream_t stream) {
    static int grid = 0;
    if (grid == 0) {
        if (n_in != 26 || in_sizes[0] != MTOK * DM || out_size != MTOK * DM || ws_size < WS_END) {
            fprintf(stderr, "kernel_launch: unexpected shapes (n_in %d, in0 %d, out %d, ws %zu; need ws >= %zu); nothing launched\n", n_in, n_in > 0 ? in_sizes[0] : -1, out_size, ws_size, (size_t)WS_END); grid = -1; return; }
        int dev = 0, cus = 0, per_cu = 0;
        if (hipGetDevice(&dev) != hipSuccess || hipDeviceGetAttribute(&cus, hipDeviceAttributeMultiprocessorCount, dev) != hipSuccess) { fprintf(stderr, "kernel_launch: device query failed\n"); grid = -1; return; }
        if (hipFuncSetAttribute((const void*)mk_fwd, hipFuncAttributeMaxDynamicSharedMemorySize, LDS_BYTES) != hipSuccess) { fprintf(stderr, "kernel_launch: hipFuncSetAttribute failed\n"); grid = -1; return; }
        if (hipOccupancyMaxActiveBlocksPerMultiprocessor(&per_cu, (const void*)mk_fwd, NWAVES * 64, LDS_BYTES) != hipSuccess || per_cu < 1) { fprintf(stderr, "kernel_launch: occupancy query reports %d workgroups per CU\n", per_cu); }
        (void)hipGetLastError();
        grid = cus;
    }
    if (grid < 0) return;
    if (hipMemsetAsync((char*)d_ws + WS_CTL, 0, CTL_ZERO_BYTES, stream) != hipSuccess) { fprintf(stderr, "kernel_launch: hipMemsetAsync failed\n"); return; }
    Args a{};
    for (int i = 0; i < 26; ++i) a.in[i] = (const float*)d_in[i];
    a.out = (float*)d_out; a.ws = (unsigned char*)d_ws;
#ifdef ABL_TWICE
    for (int rep = 0; rep < 2; ++rep) {
    if (rep) (void)hipMemsetAsync((char*)d_ws + WS_CTL, 0, CTL_ZERO_BYTES, stream);
#endif
#ifdef DBG
    {
        constexpr int last_phase = DBG == 1 ? 1 : DBG <= 4 ? 2 : DBG == 5 ? 3 : DBG == 6 ? 4 : DBG == 7 ? 5 : DBG == 8 ? 6 : DBG == 9 ? 7 : DBG == 10 ? 8 : 9;
        for (int li = 0; li <= last_phase; ++li) { a.ph_lo = li; a.ph_hi = li + 1; a.li = li; hipLaunchKernelGGL(mk_fwd, dim3(grid), dim3(NWAVES * 64), LDS_BYTES, stream, a); }
        DbgP P{}; for (int i = 0; i < 26; ++i) P.in[i] = (const float*)d_in[i]; P.ws = (unsigned char*)d_ws; P.dout = (unsigned char*)d_out; P.st = (float*)((char*)d_ws + 65536);
        if (DBG == 1) hipLaunchKernelGGL(chk_p1, dim3(375), dim3(256), 0, stream, P);
        if (DBG == 2) hipLaunchKernelGGL(chk_sgu, dim3(512), dim3(128), 0, stream, P);
        if (DBG == 3) hipLaunchKernelGGL(chk_diff, dim3(600), dim3(256), 0, stream, P);
        if (DBG == 4) hipLaunchKernelGGL(chk_mem, dim3(400), dim3(256), 0, stream, P);
        if (DBG == 5 || DBG == 6 || DBG == 7 || DBG == 9) hipLaunchKernelGGL(chk_gemm, dim3(150), dim3(256), 0, stream, P, (int)DBG);
        if (DBG == 8) hipLaunchKernelGGL(chk_ln1, dim3(128), dim3(256), 0, stream, P);
        if (DBG == 10) hipLaunchKernelGGL(chk_topk, dim3(16), dim3(256), 0, stream, P);
        if (DBG == 11) hipLaunchKernelGGL(chk_final, dim3(300), dim3(256), 0, stream, P);
        hipLaunchKernelGGL(dbg_encode, dim3(2048), dim3(256), 0, stream, (float*)d_out, (const float*)P.st, (int)DBG_PAIR);
        return;
    }
#endif
    const int nl = (N_LAUNCHES == PER_PHASE) ? PER_PHASE : 1;
    for (int li = 0; li < nl; ++li) {
        a.ph_lo = (N_LAUNCHES == PER_PHASE) ? li : 0; a.ph_hi = (N_LAUNCHES == PER_PHASE) ? li + 1 : PER_PHASE; a.li = li;
        if (N_LAUNCHES == PER_PHASE && li == REPEAT_PH) { a.pad = 1; hipLaunchKernelGGL(mk_fwd, dim3(grid), dim3(NWAVES * 64), LDS_BYTES, stream, a); a.pad = 0; }
        hipLaunchKernelGGL(mk_fwd, dim3(grid), dim3(NWAVES * 64), LDS_BYTES, stream, a);
        const hipError_t le = hipPeekAtLastError();
        if (le != hipSuccess) { fprintf(stderr, "kernel_launch: launch %d failed: %s\n", li, hipGetErrorName(le)); break; }
    }
#ifdef TSTAMP
    hipLaunchKernelGGL(ts_encode, dim3(2048), dim3(256), 0, stream, (float*)d_out, (const unsigned long long*)((char*)d_ws + 131072), (int)TSTAMP);
#endif
#ifdef ABL_TWICE
    }
#endif
}
```

```cpp
#include <hip/hip_runtime.h>
#include <cstdio>
#include <cstdint>
#include <cmath>

#ifndef SC_A
#define SC_A 1.f
#endif
#ifndef SC_B
#define SC_B 1.f
#endif
#ifndef SC_C
#define SC_C 1.f
#endif
#ifndef ABL_BR
#define ABL_BR 0
#endif
#ifndef ABL_PEER
#define ABL_PEER 0
#endif
#ifndef ABL_Y
#define ABL_Y 0
#endif
#ifdef DBG
#define MK_N_LAUNCHES 10
#ifndef DBG_PAIR
#define DBG_PAIR 0
#endif
#endif
#ifndef MK_N_LAUNCHES
#define MK_N_LAUNCHES 1
#endif

namespace pg8 {
#define PG8_LAS __attribute__((address_space(3)))
typedef unsigned short bf16_t;
typedef short bf16x8 __attribute__((ext_vector_type(8)));
typedef float f32x4 __attribute__((ext_vector_type(4)));
typedef unsigned u32x4 __attribute__((ext_vector_type(4)));
typedef unsigned u32x2 __attribute__((ext_vector_type(2)));
constexpr int BM = 256, BK = 64, HALF = 128, HTB = HALF * BK * 2  , STAGE_BYTES = 8 * HTB, NXCD = 8, WGM = 8;

__host__ __device__ __forceinline__ int lds_byte(int r, int c) { const int st = (r >> 4) * 2 + (c >> 5), rr = r & 15, cc = c & 31, ob = rr * 64 + cc * 2; return st * 1024 + (ob ^ (((ob >> 9) & 1) << 5)); }
__host__ __device__ __forceinline__ void stage_rc(int b, int& R, int& C) { const int st = b / 1024, sb = b % 1024, swz = sb ^ (((sb >> 9) & 1) << 5); R = (st >> 1) * 16 + swz / 64; C = (st & 1) * 32 + (swz % 64) / 2; }
__host__ __device__ __forceinline__ int perm32(int rho) { const int n = rho >> 4, i = rho & 15; return 8 * (i >> 2) + 4 * n + (i & 3); }

struct Unit { int pm, pn, job; };
struct Gemm { const bf16_t *A0, *A1, *A2, *A3; const bf16_t *B0, *B1, *B2, *B3; int K; };
__device__ __forceinline__ const char* jobA(const Gemm& g, int j) { return (const char*)(j == 0 ? g.A0 : j == 1 ? g.A1 : j == 2 ? g.A2 : g.A3); }
__device__ __forceinline__ const char* jobB(const Gemm& g, int j) { return (const char*)(j == 0 ? g.B0 : j == 1 ? g.B1 : j == 2 ? g.B2 : g.B3); }

struct MultiOrder {
    int nM0, nN0, nM1, nN1, nM2, nN2, nM3, nN3, s1, s2, s3, s4, G, c;
    __device__ void init(int G_, int c_, int m0, int n0, int m1 = 0, int n1 = 0, int m2 = 0, int n2 = 0, int m3 = 0, int n3 = 0) {
        nM0 = m0; nN0 = n0; nM1 = m1; nN1 = n1; nM2 = m2; nN2 = n2; nM3 = m3; nN3 = n3; s1 = m0 * n0; s2 = s1 + m1 * n1; s3 = s2 + m2 * n2; s4 = s3 + m3 * n3; G = G_; c = c_; }
    __device__ bool next(int i, Unit& u) const {
        const long L = (long)i * G + c; if (L >= s4) return false;
        int nM, nN, loc;
        if (L < s1) { u.job = 0; nM = nM0; nN = nN0; loc = (int)L; }
        else if (L < s2) { u.job = 1; nM = nM1; nN = nN1; loc = (int)L - s1; }
        else if (L < s3) { u.job = 2; nM = nM2; nN = nN2; loc = (int)L - s2; }
        else { u.job = 3; nM = nM3; nN = nN3; loc = (int)L - s3; }
        const int nwg = nM * nN; int wgid = loc; { const int q = nwg / NXCD, r = nwg % NXCD, xcd = wgid % NXCD, off = wgid / NXCD; wgid = (xcd < r ? xcd * (q + 1) : r * (q + 1) + (xcd - r) * q) + off; }
        const int nig = WGM * nN, gid = wgid / nig, fm = gid * WGM, gsz = (nM - fm) < WGM ? (nM - fm) : WGM;
        u.pm = fm + ((wgid % nig) % gsz); u.pn = (wgid % nig) / gsz; return true;
    }
    __device__ __forceinline__ void a_ready(const Unit&) const {}
    __device__ __forceinline__ void done(const Unit&) const {}
};

typedef float f32x2 __attribute__((ext_vector_type(2)));
typedef __bf16 bf16x2v __attribute__((ext_vector_type(2)));
__device__ __forceinline__ unsigned cvt_pk_bf16(float lo, float hi) { f32x2 v = {lo, hi}; bf16x2v b = __builtin_convertvector(v, bf16x2v); return __builtin_bit_cast(unsigned, b); }
__device__ __forceinline__ f32x2 gelu_pk(f32x2 v) {
    const f32x2 av = __builtin_elementwise_abs(v), d = av * 0.2316418882f + 1.0f;
    f32x2 t; t.x = __builtin_amdgcn_rcpf(d.x); t.y = __builtin_amdgcn_rcpf(d.y);
    f32x2 q = t * 0.5307027145f + (-0.7265760135f); q = q * t + 0.7107068705f; q = q * t + (-0.142248368f); q = q * t + 0.127414796f; q = q * t;
    const f32x2 s = (v * v) * (-0.72134752044f);
    f32x2 e; e.x = __builtin_amdgcn_exp2f(s.x); e.y = __builtin_amdgcn_exp2f(s.y);
    const f32x2 m = v * (q * e), r = v - m;
    f32x2 o; o.x = v.x < 0.f ? m.x : r.x; o.y = v.y < 0.f ? m.y : r.y; return o;
}
__device__ __forceinline__ float bf_lo(unsigned w) { return __uint_as_float(w << 16); }
__device__ __forceinline__ float bf_hi(unsigned w) { return __uint_as_float(w & 0xffff0000u); }
__device__ __forceinline__ float sigmoidf_(float x) { return __builtin_amdgcn_rcpf(1.0f + __builtin_amdgcn_exp2f(-1.4426950408889634f * x)); }

template <int MODE>
__device__ __forceinline__ void store_tile_bf16(const f32x4 (&acc)[2][2][4][2], bf16_t* base, int ldc, int row0, int col0, float sc, const float* bias, const bf16_t* gate) {
    f32x4 bv[2][2];
    if (MODE == 3) {
#pragma unroll
        for (int bj = 0; bj < 2; ++bj)
#pragma unroll
            for (int n = 0; n < 2; ++n) bv[bj][n] = *(const f32x4*)(bias + bj * HALF + 4 * n);
    }
#pragma unroll
    for (int ai = 0; ai < 2; ++ai)
#pragma unroll
        for (int m = 0; m < 4; ++m) { const size_t roff = (size_t)(row0 + ai * HALF + m * 16) * ldc + col0;
#pragma unroll
            for (int bj = 0; bj < 2; ++bj) { f32x4 v0 = acc[ai][bj][m][0], v1 = acc[ai][bj][m][1];
                if (MODE == 1) { f32x2 a = gelu_pk((f32x2){v0[0], v0[1]}), b = gelu_pk((f32x2){v0[2], v0[3]}), c = gelu_pk((f32x2){v1[0], v1[1]}), d = gelu_pk((f32x2){v1[2], v1[3]});
                    v0 = (f32x4){a.x, a.y, b.x, b.y}; v1 = (f32x4){c.x, c.y, d.x, d.y}; }
                if (MODE == 2) { v0 = v0 * sc; v1 = v1 * sc; }
#ifdef ABL_SNOISE
                if (MODE == 0 && sc == 2.f) { const unsigned hsh = (unsigned)(roff + bj * HALF) * 2654435761u;
#pragma unroll
                    for (int q = 0; q < 4; ++q) { const unsigned h0 = (hsh + q * 0x9E3779B9u) * 1664525u + 1013904223u, h1 = h0 * 1664525u + 1013904223u;
                        v0[q] += ((float)(h0 >> 16) * (1.f / 65536.f) - 0.5f) * 0.07f; v1[q] += ((float)(h1 >> 16) * (1.f / 65536.f) - 0.5f) * 0.07f; } }
#endif
                if (MODE == 3) { v0 = v0 + bv[bj][0]; v1 = v1 + bv[bj][1];
                    v0 = (f32x4){sigmoidf_(v0[0]), sigmoidf_(v0[1]), sigmoidf_(v0[2]), sigmoidf_(v0[3])}; v1 = (f32x4){sigmoidf_(v1[0]), sigmoidf_(v1[1]), sigmoidf_(v1[2]), sigmoidf_(v1[3])}; }
                if (MODE == 4 || MODE == 5) { const u32x4 g = *(const u32x4*)(gate + roff + bj * HALF); v0 = v0 * sc; v1 = v1 * sc;
                    v0 = v0 * (f32x4){bf_lo(g.x), bf_hi(g.x), bf_lo(g.y), bf_hi(g.y)}; v1 = v1 * (f32x4){bf_lo(g.z), bf_hi(g.z), bf_lo(g.w), bf_hi(g.w)};
                    if (MODE == 5) { const u32x4 t = __builtin_nontemporal_load((const u32x4*)(base + roff + bj * HALF));
                        v0 = v0 + (f32x4){bf_lo(t.x), bf_hi(t.x), bf_lo(t.y), bf_hi(t.y)}; v1 = v1 + (f32x4){bf_lo(t.z), bf_hi(t.z), bf_lo(t.w), bf_hi(t.w)}; } }
                u32x4 w; w.x = cvt_pk_bf16(v0[0], v0[1]); w.y = cvt_pk_bf16(v0[2], v0[3]); w.z = cvt_pk_bf16(v1[0], v1[1]); w.w = cvt_pk_bf16(v1[2], v1[3]);
                *(u32x4*)(base + roff + bj * HALF) = w; } }
}

constexpr float C_DIFF = 0.125f * 1.4426950408889634f;
constexpr float C_MEMQ = 0.0625f * 1.4426950408889634f;

struct EpiP1 {
    static constexpr bool PERM = true, AFTER_DRAIN = false;
    bf16_t *U, *V, *QD, *KD, *QM, *VDT, *KM, *VMT;
    __device__ __forceinline__ void operator()(const f32x4 (&acc)[2][2][4][2], const Unit& u, int wr, int wc, int fr, int fq) const {
        const int row0 = u.pm * BM + wr * 64 + fr, cin = wc * 32 + 8 * fq;
        if (u.job == 0) { const int t = u.pn >> 2, col0 = (u.pn & 3) * BM + cin;
            if (t == 0) store_tile_bf16<1>(acc, U, 1024, row0, col0, 1.f, nullptr, nullptr);
            else if (t == 1) store_tile_bf16<1>(acc, V, 1024, row0, col0, 1.f, nullptr, nullptr);
            else if (t == 2) store_tile_bf16<2>(acc, QD, 1024, row0, col0, C_DIFF, nullptr, nullptr);
            else if (t == 3) store_tile_bf16<0>(acc, KD, 1024, row0, col0, 1.f, nullptr, nullptr);
            else store_tile_bf16<2>(acc, QM, 1024, row0, col0, C_MEMQ, nullptr, nullptr);
        } else if (u.job == 1) store_tile_bf16<0>(acc, VDT, 32768, row0, u.pn * BM + cin, 1.f, nullptr, nullptr);
        else if (u.job == 2) store_tile_bf16<0>(acc, KM, 1024, row0, u.pn * BM + cin, 1.f, nullptr, nullptr);
        else store_tile_bf16<0>(acc, VMT, 4096, row0, u.pn * BM + cin, 1.f, nullptr, nullptr);
    }
};
struct EpiPlain {
    static constexpr bool PERM = true, AFTER_DRAIN = false;
    bf16_t* O; int ldc;
    __device__ __forceinline__ void operator()(const f32x4 (&acc)[2][2][4][2], const Unit& u, int wr, int wc, int fr, int fq) const {
        store_tile_bf16<0>(acc, O, ldc, u.pm * BM + wr * 64 + fr, u.pn * BM + wc * 32 + 8 * fq, 1.f, nullptr, nullptr);
    }
};
template <int MODE> struct EpiSplit {
    static constexpr bool PERM = true, AFTER_DRAIN = false;
    bf16_t *O0, *O1, *O2; const float* bias;
    __device__ __forceinline__ void operator()(const f32x4 (&acc)[2][2][4][2], const Unit& u, int wr, int wc, int fr, int fq) const {
        const int t = u.pn >> 2, cin = wc * 32 + 8 * fq, row0 = u.pm * BM + wr * 64 + fr, col0 = (u.pn & 3) * BM + cin; const float* bp = MODE == 3 ? bias + u.pn * BM + cin : nullptr;
        if (t == 0) store_tile_bf16<MODE>(acc, O0, 1024, row0, col0, 2.f, bp, nullptr);
        else if (t == 1) store_tile_bf16<MODE>(acc, O1, 1024, row0, col0, 2.f, bp, nullptr);
        else store_tile_bf16<MODE>(acc, O2, 1024, row0, col0, 2.f, bp, nullptr);
    }
};
struct EpiMerge {
    static constexpr bool PERM = true, AFTER_DRAIN = false;
    bf16_t* T; const bf16_t *G0, *G1, *G2;
    __device__ __forceinline__ void operator()(const f32x4 (&acc)[2][2][4][2], const Unit& u, int wr, int wc, int fr, int fq) const {
        const int row0 = u.pm * BM + wr * 64 + fr, col0 = u.pn * BM + wc * 32 + 8 * fq;
        if (u.job == 0) store_tile_bf16<4>(acc, T, 1024, row0, col0, (ABL_BR & 1) ? 0.f : SC_A, nullptr, G0);
        else if (u.job == 1) store_tile_bf16<5>(acc, T, 1024, row0, col0, (ABL_BR & 2) ? 0.f : SC_B, nullptr, G1);
        else store_tile_bf16<5>(acc, T, 1024, row0, col0, (ABL_BR & 4) ? 0.f : SC_C, nullptr, G2);
    }
};
struct EpiResid {
    static constexpr bool PERM = false, AFTER_DRAIN = false;
    const float* X; float* R; float alpha;
    __device__ __forceinline__ void operator()(const f32x4 (&acc)[2][2][4][2], const Unit& u, int wr, int wc, int fr, int fq) const {
        const int row0 = u.pm * BM + wr * 64 + fr, col0 = u.pn * BM + wc * 32 + 4 * fq;
#pragma unroll
        for (int ai = 0; ai < 2; ++ai)
#pragma unroll
            for (int m = 0; m < 4; ++m) { const size_t roff = (size_t)(row0 + ai * HALF + m * 16) * 1024 + col0;
#pragma unroll
                for (int bj = 0; bj < 2; ++bj)
#pragma unroll
                    for (int n = 0; n < 2; ++n) { const f32x4 xv = *(const f32x4*)(X + roff + bj * HALF + n * 16); *(f32x4*)(R + roff + bj * HALF + n * 16) = xv * alpha + (ABL_Y ? acc[ai][bj][m][n] * 0.f : acc[ai][bj][m][n]); } }
    }
};

template <class Epi, class Sched, bool ALIGN_EPI = false, bool SP2 = false>
__device__ __forceinline__ void gemm_phase(PG8_LAS unsigned char* lds, const Gemm g, const Sched& S, const Epi& E) {
    const int tid = threadIdx.x, wid = __builtin_amdgcn_readfirstlane(tid >> 6), lane = tid & 63, wr = wid >> 2, wc = wid & 3, fr = lane & 15, fq = lane >> 4;
    const int K = g.K, nt = K / BK;
    unsigned voffA[2], voffB[2];
#pragma unroll
    for (int i = 0; i < 2; ++i) { int R, C; stage_rc(tid * 16 + i * 8192, R, C); const int Rb = Epi::PERM ? ((R & ~31) + perm32(R & 31)) : R;
        voffA[i] = (unsigned)(R * K + C) * 2u; voffB[i] = (unsigned)(Rb * K + C) * 2u; }
    const size_t kstep = (size_t)(BK * 2);
    const size_t hstep = (size_t)HALF * K * 2;
    const size_t tstep = 2 * hstep;
    const unsigned ldsw = (unsigned)wid * 1024u;
    const int aoff = lds_byte(wr * 64 + fr, fq * 8), boff = lds_byte(wc * 32 + fr, fq * 8);
#define PG8_SA(b, h) (((b) * 2 + (h)) * HTB)
#define PG8_SB(b, h) ((4 + (b) * 2 + (h)) * HTB)
#define PG8_STAGE(bufoff, gbase, voff) do { _Pragma("unroll") for (int _i = 0; _i < 2; ++_i) \
        __builtin_amdgcn_global_load_lds((const unsigned*)((const char*)(gbase) + (voff)[_i]), (PG8_LAS unsigned*)(lds + (bufoff) + ldsw + _i * 8192), 16, 0, 0); } while (0)
#define PG8_LDA(dst, b, h) do { _Pragma("unroll") for (int m = 0; m < 4; ++m) _Pragma("unroll") for (int k = 0; k < 2; ++k) dst[m][k] = *(const PG8_LAS bf16x8*)(lds + PG8_SA(b, h) + aoff + m * 2048 + k * 1024); } while (0)
#define PG8_LDB(dst, b, h) do { _Pragma("unroll") for (int n = 0; n < 2; ++n) _Pragma("unroll") for (int k = 0; k < 2; ++k) dst[n][k] = *(const PG8_LAS bf16x8*)(lds + PG8_SB(b, h) + boff + n * 2048 + k * 1024); } while (0)
#define PG8_MMA(ai, bj, At, Bt) do { __builtin_amdgcn_s_setprio(1); _Pragma("unroll") for (int m = 0; m < 4; ++m) _Pragma("unroll") for (int n = 0; n < 2; ++n) _Pragma("unroll") for (int k = 0; k < 2; ++k) \
        acc[ai][bj][m][n] = __builtin_amdgcn_mfma_f32_16x16x32_bf16(Bt[n][k], At[m][k], acc[ai][bj][m][n], 0, 0, 0); __builtin_amdgcn_s_setprio(0); } while (0)
#define PG8_WAIT_V(n) asm volatile("s_waitcnt vmcnt(" #n ")" ::: "memory")
#define PG8_WAIT_L(n) asm volatile("s_waitcnt lgkmcnt(" #n ")" ::: "memory")
#define PG8_BAR __builtin_amdgcn_s_barrier()
#define PG8_SCHED __builtin_amdgcn_sched_barrier(0)
    Unit cur, nxt; int ui = 0;
    if (!S.next(0, cur)) return;
    f32x4 acc[2][2][4][2];
#pragma unroll
    for (int a = 0; a < 2; ++a)
#pragma unroll
        for (int b = 0; b < 2; ++b)
#pragma unroll
            for (int m = 0; m < 4; ++m)
#pragma unroll
                for (int n = 0; n < 2; ++n) acc[a][b][m][n] = (f32x4){0.f, 0.f, 0.f, 0.f};
    bf16x8 At[4][2], B0[2][2], B1[2][2];
    const char* cA = jobA(g, cur.job) + (size_t)cur.pm * tstep; const char* cB = jobB(g, cur.job) + (size_t)cur.pn * tstep;
    S.a_ready(cur);
    if constexpr (SP2) {
        PG8_STAGE(PG8_SB(0, 0), cB, voffB); PG8_STAGE(PG8_SB(0, 1), cB + hstep, voffB); PG8_STAGE(PG8_SA(0, 0), cA, voffA); PG8_STAGE(PG8_SA(0, 1), cA + hstep, voffA);
        if (wr == 1) PG8_BAR;
        PG8_WAIT_V(2); PG8_BAR;
        PG8_STAGE(PG8_SB(1, 0), cB + kstep, voffB); PG8_STAGE(PG8_SA(1, 0), cA + kstep, voffA); PG8_STAGE(PG8_SB(1, 1), cB + hstep + kstep, voffB);
        PG8_WAIT_V(6); PG8_BAR;
    } else {
        PG8_STAGE(PG8_SB(0, 0), cB, voffB); PG8_STAGE(PG8_SA(0, 0), cA, voffA); PG8_STAGE(PG8_SB(0, 1), cB + hstep, voffB); PG8_STAGE(PG8_SA(0, 1), cA + hstep, voffA);
        if (wr == 1) PG8_BAR;
        PG8_WAIT_V(4); PG8_BAR;
        PG8_STAGE(PG8_SB(1, 0), cB + kstep, voffB); PG8_STAGE(PG8_SA(1, 0), cA + kstep, voffA); PG8_STAGE(PG8_SB(1, 1), cB + hstep + kstep, voffB);
        PG8_WAIT_V(6); PG8_BAR;
    }
    for (;;) {
        const bool has_next = S.next(ui + 1, nxt);
        const char* nA = has_next ? jobA(g, nxt.job) + (size_t)nxt.pm * tstep : cA; const char* nB = has_next ? jobB(g, nxt.job) + (size_t)nxt.pn * tstep : cB;
        for (int t = 0; t < nt; t += 2) {
            const bool last = (t == nt - 2);
            const char* a1 = cA + (size_t)(t + 1) * kstep;
            const char* a2 = last ? nA : cA + (size_t)(t + 2) * kstep; const char* b2 = last ? nB : cB + (size_t)(t + 2) * kstep;
            const char* a3 = a2 + kstep; const char* b3 = b2 + kstep;
            if (last && has_next) S.a_ready(nxt);
            if constexpr (SP2) {
            PG8_LDB(B0, 0, 0); PG8_LDB(B1, 0, 1); PG8_SCHED; PG8_LDA(At, 0, 0); PG8_STAGE(PG8_SA(1, 1), a1 + hstep, voffA);
            PG8_WAIT_V(8); PG8_WAIT_L(0); PG8_BAR; PG8_MMA(0, 0, At, B0); PG8_MMA(0, 1, At, B1); PG8_BAR; PG8_SCHED;
            PG8_LDA(At, 0, 1); PG8_STAGE(PG8_SB(0, 0), b2, voffB); PG8_STAGE(PG8_SB(0, 1), b2 + hstep, voffB); PG8_STAGE(PG8_SA(0, 0), a2, voffA);
            PG8_WAIT_V(8); PG8_WAIT_L(0); PG8_BAR; PG8_MMA(1, 0, At, B0); PG8_MMA(1, 1, At, B1); PG8_BAR; PG8_SCHED;
            PG8_LDB(B0, 1, 0); PG8_LDB(B1, 1, 1); PG8_SCHED; PG8_LDA(At, 1, 0); PG8_STAGE(PG8_SA(0, 1), a2 + hstep, voffA);
            PG8_WAIT_V(8); PG8_WAIT_L(0); PG8_BAR; PG8_MMA(0, 0, At, B0); PG8_MMA(0, 1, At, B1); PG8_BAR; PG8_SCHED;
            PG8_LDA(At, 1, 1); PG8_STAGE(PG8_SB(1, 0), b3, voffB); PG8_STAGE(PG8_SB(1, 1), b3 + hstep, voffB); PG8_STAGE(PG8_SA(1, 0), a3, voffA);
            PG8_WAIT_V(8); PG8_WAIT_L(0); PG8_BAR; PG8_MMA(1, 0, At, B0); PG8_MMA(1, 1, At, B1); PG8_BAR; PG8_SCHED;
            } else {
            PG8_LDB(B0, 0, 0); PG8_SCHED; PG8_LDA(At, 0, 0); PG8_STAGE(PG8_SA(1, 1), a1 + hstep, voffA);
            PG8_WAIT_L(8); PG8_BAR; PG8_WAIT_L(0); PG8_MMA(0, 0, At, B0); PG8_BAR; PG8_SCHED;
            PG8_LDB(B1, 0, 1); PG8_STAGE(PG8_SB(0, 0), b2, voffB);
            PG8_BAR; PG8_WAIT_L(0); PG8_MMA(0, 1, At, B1); PG8_BAR;
            PG8_LDA(At, 0, 1); PG8_STAGE(PG8_SA(0, 0), a2, voffA);
            PG8_BAR; PG8_WAIT_L(0); PG8_MMA(1, 0, At, B0); PG8_BAR; PG8_SCHED;
            PG8_STAGE(PG8_SB(0, 1), b2 + hstep, voffB);
            PG8_WAIT_V(6); PG8_BAR; PG8_MMA(1, 1, At, B1); PG8_BAR;
            PG8_LDB(B0, 1, 0); PG8_SCHED; PG8_LDA(At, 1, 0); PG8_STAGE(PG8_SA(0, 1), a2 + hstep, voffA);
            PG8_WAIT_L(8); PG8_BAR; PG8_WAIT_L(0); PG8_MMA(0, 0, At, B0); PG8_BAR; PG8_SCHED;
            PG8_LDB(B1, 1, 1); PG8_STAGE(PG8_SB(1, 0), b3, voffB);
            PG8_BAR; PG8_WAIT_L(0); PG8_MMA(0, 1, At, B1); PG8_BAR;
            PG8_LDA(At, 1, 1); PG8_STAGE(PG8_SA(1, 0), a3, voffA);
            PG8_BAR; PG8_WAIT_L(0); PG8_MMA(1, 0, At, B0); PG8_BAR; PG8_SCHED;
            PG8_STAGE(PG8_SB(1, 1), b3 + hstep, voffB);
            PG8_WAIT_V(6); PG8_BAR; PG8_MMA(1, 1, At, B1); PG8_BAR;
            }
        }
        if constexpr (ALIGN_EPI) { if (wr == 0) PG8_BAR; }
        if constexpr (!Epi::AFTER_DRAIN) { E(acc, cur, wr, wc, fr, fq); S.done(cur); }
        if (!has_next) break;
#pragma unroll
        for (int a = 0; a < 2; ++a)
#pragma unroll
            for (int b = 0; b < 2; ++b)
#pragma unroll
                for (int m = 0; m < 4; ++m)
#pragma unroll
                    for (int n = 0; n < 2; ++n) acc[a][b][m][n] = (f32x4){0.f, 0.f, 0.f, 0.f};
        cur = nxt; cA = nA; cB = nB; ++ui;
        if constexpr (ALIGN_EPI) { if (wr == 1) PG8_BAR; }
    }
    PG8_WAIT_V(0);
    if constexpr (!ALIGN_EPI) { if (wr == 0) PG8_BAR; }
    PG8_BAR;
    if constexpr (Epi::AFTER_DRAIN) { E.fused(acc, cur, wr, wc, fr, fq, lds, wid, lane); S.done(cur); }
#undef PG8_SA
#undef PG8_SB
#undef PG8_STAGE
#undef PG8_LDA
#undef PG8_LDB
#undef PG8_MMA
#undef PG8_WAIT_V
#undef PG8_WAIT_L
#undef PG8_BAR
#undef PG8_SCHED
}
}
#ifndef DRYMASK
#define DRYMASK 7
#endif
#ifndef MIXSC
#define MIXSC 1.f
#endif
#ifndef BIASSC
#define BIASSC 1.f
#endif

constexpr int NWAVES = 8;
constexpr int N_LAUNCHES = MK_N_LAUNCHES;
constexpr int PER_PHASE = 10;
constexpr int BATCH = 16, SEQ = 2048, DM = 1024, MTOK = BATCH * SEQ, MEML = 256, MMEM = BATCH * MEML;
constexpr int NEXP = 16384;
constexpr float ALPHA = 1.189207115002721f;
constexpr float LN_EPS = 1e-5f;
constexpr float LAM_INIT = 0.2f;
constexpr float LOG2E = 1.4426950408889634f;

constexpr size_t MiB = 1u << 20;
constexpr size_t WS_CTL = 0, CTL_ZERO_BYTES = 1 * MiB;
constexpr size_t WS_W1T = 1 * MiB;
constexpr size_t WS_WVDT = 11 * MiB;
constexpr size_t WS_WGT = 13 * MiB;
constexpr size_t WS_WMKT = 19 * MiB;
constexpr size_t WS_WMVT = 21 * MiB;
constexpr size_t WS_WBT = 23 * MiB;
constexpr size_t WS_WOT = 29 * MiB;
constexpr size_t WS_WPQ = 31 * MiB;
constexpr size_t WS_SKD = 35 * MiB;
constexpr size_t WS_WST = 43 * MiB;
constexpr size_t WS_A0 = 48 * MiB, ACT_BYTES = 64 * MiB;
constexpr size_t WS_END = WS_A0 + 7 * ACT_BYTES;
constexpr size_t DO_XB = 0, DO_MEMB = 64 * MiB, DO_KM = 72 * MiB, DO_VMT = 80 * MiB;
constexpr int CW_TMO = 0, CW_CODE = 1, CW_BAR = 4096;

constexpr int RING_OFF = 0, RING_BYTES = 135168;
constexpr int LDSCTL_OFF = RING_BYTES, MISC_OFF = LDSCTL_OFF + 320;
constexpr int LDS_BYTES = 147456;
static_assert(MISC_OFF + 128 <= LDS_BYTES, "LDS map");

#define GAS __attribute__((address_space(1)))
#define LAS __attribute__((address_space(3)))
typedef unsigned short bf16;
typedef unsigned v4u __attribute__((ext_vector_type(4)));
typedef unsigned v2u __attribute__((ext_vector_type(2)));
typedef float f32x4 __attribute__((ext_vector_type(4)));
typedef float f32x16 __attribute__((ext_vector_type(16)));
typedef short bf16x8 __attribute__((ext_vector_type(8)));
typedef __bf16 bf16x2_t __attribute__((ext_vector_type(2)));
typedef float f32x2_t __attribute__((ext_vector_type(2)));
typedef GAS unsigned gu32;
#define RLX_AGENT __ATOMIC_RELAXED, __HIP_MEMORY_SCOPE_AGENT
#define LDS_WAIT() asm volatile("s_waitcnt lgkmcnt(0)" ::: "memory")
#define VM_WAIT() asm volatile("s_waitcnt vmcnt(0)" ::: "memory")
__device__ __forceinline__ unsigned f2bf(float f) { unsigned u = __builtin_bit_cast(unsigned, f); return (u + 0x7fffu + ((u >> 16) & 1u)) >> 16; }
__device__ __forceinline__ unsigned pk2(float lo, float hi) { f32x2_t v = {lo, hi}; bf16x2_t b = __builtin_convertvector(v, bf16x2_t); return __builtin_bit_cast(unsigned, b); }
__device__ __forceinline__ float bflo(unsigned w) { return __uint_as_float(w << 16); }
__device__ __forceinline__ float bfhi(unsigned w) { return __uint_as_float(w & 0xffff0000u); }
__device__ __forceinline__ float dot2_bf16(unsigned a, unsigned b, float acc) { return __builtin_amdgcn_fdot2_f32_bf16(__builtin_bit_cast(bf16x2_t, a), __builtin_bit_cast(bf16x2_t, b), acc, false); }
__device__ __forceinline__ float wave_sum(float v) {
#pragma unroll
    for (int o = 1; o < 64; o <<= 1) v += __shfl_xor(v, o);
    return v;
}
__device__ __forceinline__ float gelu1(float v) { pg8::f32x2 r = pg8::gelu_pk((pg8::f32x2){v, v}); return r.x; }

#define XB_TMO      128
#define XB_XCNT(j)  (256  + 64 * (j))
#define XB_XSUB(j)  (1280 + 64 * (j))
#define XB_XGEN(j)  (2304 + 64 * (j))
#define XB_TOP      3328
#define XB_TOPGEN   3392
#define XCD_BAR_WORDS 3456
#define XB_SPIN_CAP (1u << 22)

__device__ __forceinline__ unsigned xb_ld(unsigned* p)              { return __hip_atomic_load(p, __ATOMIC_RELAXED, __HIP_MEMORY_SCOPE_AGENT); }
__device__ __forceinline__ unsigned xb_add(unsigned* p, unsigned v) { return __hip_atomic_fetch_add(p, v, __ATOMIC_RELAXED, __HIP_MEMORY_SCOPE_AGENT); }
__device__ __forceinline__ unsigned xb_xcc_id() { return (unsigned)__builtin_amdgcn_s_getreg((3 << 11) | 20) & 0xFu; }
#define XB_SPIN(cond, bar) do { unsigned _sp = 0; while (cond) { __builtin_amdgcn_s_sleep(1); \
    if ((++_sp & 255u) == 0u) { if (xb_ld(&(bar)[XB_TMO])) break; if (_sp > XB_SPIN_CAP) { atomicAdd(&(bar)[XB_TMO], 1u); break; } } } } while (0)

struct XcdBarrier { unsigned* bar; unsigned x; volatile LAS unsigned* st; };

__device__ __forceinline__ XcdBarrier xcd_barrier_post(unsigned* bar, volatile LAS unsigned* st) {
    XcdBarrier b; b.bar = bar; b.x = xb_xcc_id(); b.st = st;
    if (threadIdx.x == 0) (void)xb_add(&bar[XB_XCNT(b.x)], 1u);
    return b;
}
__device__ __forceinline__ void xcd_barrier_complete(unsigned* bar, unsigned x, unsigned& nloc, unsigned& nx) {
    const unsigned G = gridDim.x * gridDim.y * gridDim.z;
    unsigned sum, cnt, mine, sp = 0u;
    for (;;) {
        sum = 0u; cnt = 0u; mine = 0u;
#pragma unroll
        for (unsigned j = 0; j < 16; ++j) { const unsigned c = xb_ld(&bar[XB_XCNT(j)]); sum += c; cnt += (c > 0u) ? 1u : 0u; mine = (j == x) ? c : mine; }
        if (sum == G) break;
        __builtin_amdgcn_s_sleep(1);
        if ((++sp & 255u) == 0u) { if (xb_ld(&bar[XB_TMO])) break; if (sp > XB_SPIN_CAP) { atomicAdd(&bar[XB_TMO], 1u); break; } }
    }
    nloc = mine > 0u ? mine : 1u; nx = cnt > 0u ? cnt : 1u;
}
__device__ __forceinline__ void xcd_barrier(const XcdBarrier& b) {
    asm volatile("s_waitcnt vmcnt(0)" ::: "memory");
    __syncthreads();
    if (threadIdx.x == 0) {
        unsigned* bar = b.bar;
        __builtin_amdgcn_s_waitcnt(0);
        unsigned nloc = b.st[0], nx = b.st[1];
        if (nloc == 0u) { xcd_barrier_complete(bar, b.x, nloc, nx); b.st[0] = nloc; b.st[1] = nx; }
        const unsigned old = xb_add(&bar[XB_XSUB(b.x)], 1u);
        const unsigned gen = old / nloc;
        if (old + 1u == (gen + 1u) * nloc) {
            __builtin_amdgcn_fence(__ATOMIC_RELEASE, "agent");
            asm volatile("s_waitcnt vmcnt(0)" ::: "memory");
            const unsigned og = xb_add(&bar[XB_TOP], 1u);
            const unsigned tg = og / nx;
            if (og + 1u == (tg + 1u) * nx) xb_add(&bar[XB_TOPGEN], 1u);
            else XB_SPIN(xb_ld(&bar[XB_TOPGEN]) == tg, bar);
            __builtin_amdgcn_fence(__ATOMIC_ACQUIRE, "agent");
            xb_add(&bar[XB_XGEN(b.x)], 1u);
            asm volatile("s_waitcnt vmcnt(0)" ::: "memory");
        } else {
            XB_SPIN(xb_ld(&bar[XB_XGEN(b.x)]) == gen, bar);
            __builtin_amdgcn_fence(__ATOMIC_ACQUIRE, "agent");
            asm volatile("s_waitcnt vmcnt(0)" ::: "memory");
        }
    }
    __syncthreads();
}

struct Args { const float* in[26]; float* out; unsigned char* ws; int ph_lo, ph_hi, li, pad; };
struct Frame {
    LAS unsigned char* lds;
    volatile LAS unsigned* MISC;
    gu32* ctl;
    int tid, lane, wave;
    int vcu, G;
    unsigned char* ws; unsigned char* dout;
};
__device__ __forceinline__ bf16* wsb(const Frame& F, size_t off) { return (bf16*)(F.ws + off); }
__device__ __forceinline__ bf16* act(const Frame& F, int i) { return (bf16*)(F.ws + WS_A0 + (size_t)i * ACT_BYTES); }

__device__ __forceinline__ void p0_transpose_item(const float* W, int ldw, int col_off, int ncols, int K, bf16* WT, int row_off, LAS float* scr, int item, int lane) {
    const int nblk = ncols / 32, kb = item / nblk, nb = item % nblk, k0 = 64 * kb, n0 = 32 * nb;
#pragma unroll 8
    for (int i = 0; i < 32; ++i) { const int kk = 2 * i + (lane >> 5); scr[kk * 33 + (lane & 31)] = W[(size_t)(k0 + kk) * ldw + col_off + n0 + (lane & 31)]; }
    LDS_WAIT(); asm volatile("" ::: "memory");
    const int c = lane & 7;
#pragma unroll
    for (int j = 0; j < 4; ++j) { const int n = (lane >> 3) + 8 * j; const LAS float* s = scr + (8 * c) * 33 + n;
        v4u o; o.x = pk2(s[0 * 33], s[1 * 33]); o.y = pk2(s[2 * 33], s[3 * 33]); o.z = pk2(s[4 * 33], s[5 * 33]); o.w = pk2(s[6 * 33], s[7 * 33]);
        *(GAS v4u*)(WT + (size_t)(row_off + n0 + n) * K + k0 + 8 * c) = o; }
    LDS_WAIT(); asm volatile("" ::: "memory");
}
__device__ __forceinline__ void cvt_row_1024(const float* src, bf16* dst, int lane) {
    const GAS f32x4* xr = (const GAS f32x4*)src + lane;
    GAS v2u* o8 = (GAS v2u*)dst + lane;
    f32x4 v[4];
#pragma unroll
    for (int j = 0; j < 4; ++j) v[j] = xr[64 * j];
#pragma unroll
    for (int j = 0; j < 4; ++j) { v2u w; w.x = pk2(v[j].x, v[j].y); w.y = pk2(v[j].z, v[j].w); o8[64 * j] = w; }
}
__device__ __forceinline__ void cvt_row_fp8(const float* src, unsigned char* dst, float* inv_out, int lane) {
    f32x4 v[4];
#pragma unroll
    for (int j = 0; j < 4; ++j) v[j] = *(const GAS f32x4*)(src + 16 * lane + 4 * j);
    float am = 0.f;
#pragma unroll
    for (int j = 0; j < 4; ++j) am = fmaxf(am, fmaxf(fmaxf(fabsf(v[j].x), fabsf(v[j].y)), fmaxf(fabsf(v[j].z), fabsf(v[j].w))));
#pragma unroll
    for (int o = 1; o < 64; o <<= 1) am = fmaxf(am, __shfl_xor(am, o));
    int E = (int)((__float_as_uint(am) >> 23) & 0xffu); E = E < 8 ? 8 : (E > 250 ? 250 : E);
    const float sc = __uint_as_float((unsigned)(260 - E) << 23), inv = __uint_as_float((unsigned)(E - 6) << 23);
    v4u o; unsigned w;
#pragma unroll
    for (int j = 0; j < 4; ++j) { w = (unsigned)__builtin_amdgcn_cvt_pk_fp8_f32(v[j].x * sc, v[j].y * sc, 0, false); w = (unsigned)__builtin_amdgcn_cvt_pk_fp8_f32(v[j].z * sc, v[j].w * sc, (int)w, true); o[j] = w; }
    *(GAS v4u*)(dst + 16 * lane) = o;
    if (lane == 0) *inv_out = inv;
}
__device__ __forceinline__ void p0_prologue(Frame& F, const Args& A) {
    LAS float* scr = (LAS float*)(F.lds + RING_OFF + F.wave * 16384);
    const int gw = F.vcu * NWAVES + F.wave, NGW = F.G * NWAVES;
    const float *w_in = A.in[2], *w_mkv = A.in[13], *w_gate = A.in[14], *w_br = A.in[16], *w_out = A.in[17];
    constexpr int I_IN0 = 16 * 128, I_INV = 16 * 32, I_INM = 16 * 32, I_G = 16 * 96, I_MK = 16 * 32, I_MV = 16 * 32, I_BR = 16 * 32, I_O = 16 * 32;
    constexpr int NT = I_IN0 + I_INV + I_INM + I_G + I_MK + I_MV + 3 * I_BR + I_O;
    for (int it = gw; it < NT; it += NGW) {
        int r = it;
        if (r < I_IN0) { p0_transpose_item(w_in, 6144, 0, 4096, 1024, wsb(F, WS_W1T), 0, scr, r, F.lane); continue; } r -= I_IN0;
        if (r < I_INV) { p0_transpose_item(w_in, 6144, 4096, 1024, 1024, wsb(F, WS_WVDT), 0, scr, r, F.lane); continue; } r -= I_INV;
        if (r < I_INM) { p0_transpose_item(w_in, 6144, 5120, 1024, 1024, wsb(F, WS_W1T), 4096, scr, r, F.lane); continue; } r -= I_INM;
        if (r < I_G) { p0_transpose_item(w_gate, 3072, 0, 3072, 1024, wsb(F, WS_WGT), 0, scr, r, F.lane); continue; } r -= I_G;
        if (r < I_MK) { p0_transpose_item(w_mkv, 2048, 0, 1024, 1024, wsb(F, WS_WMKT), 0, scr, r, F.lane); continue; } r -= I_MK;
        if (r < I_MV) { p0_transpose_item(w_mkv, 2048, 1024, 1024, 1024, wsb(F, WS_WMVT), 0, scr, r, F.lane); continue; } r -= I_MV;
        if (r < 3 * I_BR) { const int n = r / I_BR; p0_transpose_item(w_br + (size_t)n * 1024 * 1024, 1024, 0, 1024, 1024, wsb(F, WS_WBT) + (size_t)n * 1024 * 1024, 0, scr, r % I_BR, F.lane); continue; } r -= 3 * I_BR;
        p0_transpose_item(w_out, 1024, 0, 1024, 1024, wsb(F, WS_WOT), 0, scr, r, F.lane);
    }
    bf16* XB = (bf16*)(F.dout + DO_XB); bf16* MEMB = (bf16*)(F.dout + DO_MEMB);
    for (int m = gw; m < MTOK; m += NGW) cvt_row_1024(A.in[0] + (size_t)m * 1024, XB + (size_t)m * 1024, F.lane);
    for (int m = gw; m < MMEM; m += NGW) cvt_row_1024(A.in[1] + (size_t)m * 1024, MEMB + (size_t)m * 1024, F.lane);
    for (int m = gw; m < 2048; m += NGW) cvt_row_1024(A.in[20] + (size_t)m * 1024, wsb(F, WS_WPQ) + (size_t)m * 1024, F.lane);
    const float* sk = A.in[21];
    for (int r = gw; r < 2048; r += NGW) {
        const int cb = (r >> 7) << 7;
#pragma unroll
        for (int j = 0; j < 4; ++j) { const int c0 = 8 * (F.lane + 64 * j); v4u o = {0u, 0u, 0u, 0u};
            if (c0 >= cb && c0 < cb + 128) { const f32x4 a = *(const GAS f32x4*)(sk + (size_t)r * 128 + (c0 - cb)), b = *(const GAS f32x4*)(sk + (size_t)r * 128 + (c0 - cb) + 4);
                o.x = pk2(a.x, a.y); o.y = pk2(a.z, a.w); o.z = pk2(b.x, b.y); o.w = pk2(b.z, b.w); }
            *(GAS v4u*)(wsb(F, WS_SKD) + (size_t)r * 2048 + c0) = o; }
    }
}

#define MFMA32(a, b, c) __builtin_amdgcn_mfma_f32_32x32x16_bf16((a), (b), (c), 0, 0, 0)
__device__ __forceinline__ int crow(int r, int hi) { return (r & 3) + 8 * (r >> 2) + 4 * hi; }
__device__ __forceinline__ int swap23(int x) { return (x & ~12) | ((x & 4) << 1) | ((x & 8) >> 1); }
constexpr int P2_KBUF = 33792, P2_VBUF = 18432, P2_VROWB = 144;
constexpr int P2_K0 = 0, P2_V0 = 2 * P2_KBUF, P2_BT = RING_BYTES - 2048, P2_SG = P2_BT + 512, P2_LAM = P2_SG + 512, P2_END = P2_LAM + 64;
static_assert(P2_V0 + 2 * P2_VBUF <= P2_BT && P2_END <= RING_BYTES, "P2 LDS");

template <int KSTEPS, bool BAND, bool QHOLD>
__device__ __forceinline__ void attn_pass(LAS unsigned char* lds, const bf16* qrow, const bf16* Kg, int kpitch, const bf16* Vg, int vpitch,
                                          int ntiles, int my_last, int band_first, int qpos, f32x16 (&O)[4], float& l_out) {
    constexpr int KROWB = KSTEPS * 32 + 16, KCH = KSTEPS * 2, KPT = (64 * KCH) / 512;
    static_assert(64 * KROWB <= P2_KBUF, "K tile");
    const int tid = threadIdx.x, lane = tid & 63, r = lane & 31, hi = lane >> 5;
    const LAS float* btab = (const LAS float*)(lds + P2_BT);
    v4u kreg[KPT], vreg[2];
    const bf16* ksrc[KPT]; int kdst[KPT]; const bf16* vsrc[2]; int vdst[2];
#pragma unroll
    for (int i = 0; i < KPT; ++i) { const int c = tid + 512 * i, row = c / KCH, part = c % KCH; ksrc[i] = Kg + (size_t)row * kpitch + part * 8; kdst[i] = ((row & 0x30) | swap23(row & 15)) * KROWB + part * 16; }
#pragma unroll
    for (int i = 0; i < 2; ++i) { const int c = tid + 512 * i, row = c >> 3, part = c & 7; vsrc[i] = Vg + (size_t)row * vpitch + part * 8; vdst[i] = row * P2_VROWB + part * 16; }
#pragma unroll
    for (int d = 0; d < 4; ++d) O[d] = f32x16{};
    float m_run = -1e30f, l_run = 0.f;
    bf16x8 qf[QHOLD ? KSTEPS : 1];
    if (QHOLD) {
#pragma unroll
        for (int ks = 0; ks < KSTEPS; ++ks) qf[QHOLD ? ks : 0] = *(const GAS bf16x8*)(qrow + ks * 16);
    }
#pragma unroll
    for (int i = 0; i < KPT; ++i) kreg[i] = *(const GAS v4u*)(ksrc[i]);
#pragma unroll
    for (int i = 0; i < 2; ++i) vreg[i] = *(const GAS v4u*)(vsrc[i]);
#pragma unroll
    for (int i = 0; i < KPT; ++i) *(LAS v4u*)(lds + P2_K0 + kdst[i]) = kreg[i];
#pragma unroll
    for (int i = 0; i < 2; ++i) *(LAS v4u*)(lds + P2_V0 + vdst[i]) = vreg[i];
    __syncthreads();
    for (int t = 0; t < ntiles; ++t) {
        const int cur = t & 1; const bool more = (t + 1 < ntiles);
        if (more) {
#pragma unroll
            for (int i = 0; i < KPT; ++i) kreg[i] = *(const GAS v4u*)(ksrc[i] + (size_t)(t + 1) * 64 * kpitch);
#pragma unroll
            for (int i = 0; i < 2; ++i) vreg[i] = *(const GAS v4u*)(vsrc[i] + (t + 1) * 64);
        }
        if (t <= my_last) {
            const LAS unsigned char* kb = lds + P2_K0 + cur * P2_KBUF + r * KROWB + hi * 16;
            const LAS unsigned char* vb = lds + P2_V0 + cur * P2_VBUF + r * P2_VROWB + hi * 16;
            f32x16 p0 = f32x16{}, p1 = f32x16{};
#pragma unroll
            for (int ks = 0; ks < KSTEPS; ++ks) {
                const bf16x8 a0 = *(const LAS bf16x8*)(kb + ks * 32), a1 = *(const LAS bf16x8*)(kb + 32 * KROWB + ks * 32);
                const bf16x8 qq = QHOLD ? qf[QHOLD ? ks : 0] : *(const GAS bf16x8*)(qrow + ks * 16);
                p0 = MFMA32(a0, qq, p0); p1 = MFMA32(a1, qq, p1);
            }
            if (BAND && t >= band_first) {
                const int kv0 = t * 64;
#pragma unroll
                for (int e = 0; e < 16; ++e) {
                    const int kl = swap23(crow(e, 0)) + 8 * hi;
                    const int rel0 = qpos - (kv0 + kl), rel1 = rel0 - 32;
                    const float b0 = btab[rel0 < 0 ? 0 : (rel0 > 127 ? 127 : rel0)], b1 = btab[rel1 < 0 ? 0 : (rel1 > 127 ? 127 : rel1)];
                    p0[e] = rel0 < 0 ? -1e30f : p0[e] + b0; p1[e] = rel1 < 0 ? -1e30f : p1[e] + b1;
                }
            }
            float mx = fmaxf(p0[0], p1[0]);
#pragma unroll
            for (int e = 1; e < 16; ++e) mx = fmaxf(mx, fmaxf(p0[e], p1[e]));
            mx = fmaxf(mx, __shfl_xor(mx, 32));
            const float m_new = fmaxf(m_run, mx), alpha = __builtin_amdgcn_exp2f(m_run - m_new);
            m_run = m_new;
            float ps = 0.f;
#pragma unroll
            for (int e = 0; e < 16; ++e) { p0[e] = __builtin_amdgcn_exp2f(p0[e] - m_new); p1[e] = __builtin_amdgcn_exp2f(p1[e] - m_new); ps += p0[e] + p1[e]; }
            l_run = l_run * alpha + ps;
#pragma unroll
            for (int d = 0; d < 4; ++d) O[d] = O[d] * alpha;
            bf16x8 pk[4];
#pragma unroll
            for (int s = 0; s < 2; ++s) {
                v4u w0, w1;
                w0.x = pk2(p0[8 * s + 0], p0[8 * s + 1]); w0.y = pk2(p0[8 * s + 2], p0[8 * s + 3]); w0.z = pk2(p0[8 * s + 4], p0[8 * s + 5]); w0.w = pk2(p0[8 * s + 6], p0[8 * s + 7]);
                w1.x = pk2(p1[8 * s + 0], p1[8 * s + 1]); w1.y = pk2(p1[8 * s + 2], p1[8 * s + 3]); w1.z = pk2(p1[8 * s + 4], p1[8 * s + 5]); w1.w = pk2(p1[8 * s + 6], p1[8 * s + 7]);
                pk[s] = __builtin_bit_cast(bf16x8, w0); pk[2 + s] = __builtin_bit_cast(bf16x8, w1);
            }
#pragma unroll
            for (int d = 0; d < 4; ++d)
#pragma unroll
                for (int s = 0; s < 4; ++s) { const bf16x8 a = *(const LAS bf16x8*)(vb + d * 32 * P2_VROWB + s * 32); O[d] = MFMA32(a, pk[s], O[d]); }
        }
        if (more) {
            const int nb = cur ^ 1;
#pragma unroll
            for (int i = 0; i < KPT; ++i) *(LAS v4u*)(lds + P2_K0 + nb * P2_KBUF + kdst[i]) = kreg[i];
#pragma unroll
            for (int i = 0; i < 2; ++i) *(LAS v4u*)(lds + P2_V0 + nb * P2_VBUF + vdst[i]) = vreg[i];
        }
        __syncthreads();
    }
    l_out = l_run + __shfl_xor(l_run, 32);
}

constexpr int DF_KBUF = 16384, DF_VBUF = 16384, DF_K0 = 0, DF_V0 = 2 * DF_KBUF, DF_Q0 = DF_V0 + 2 * DF_VBUF;
static_assert(DF_Q0 + 8 * 8192 <= P2_BT, "diff LDS");
constexpr float DF_THR = 6.0f;
__device__ __forceinline__ void glds16(const void* gsrc, unsigned lds_dst) { unsigned keep;
    asm volatile("s_mov_b32 %0, m0\n\ts_mov_b32 m0, %2\n\ts_nop 0\n\tglobal_load_lds_dwordx4 %1, off\n\ts_mov_b32 m0, %0" : "=&s"(keep) : "v"(gsrc), "s"(lds_dst) : "memory"); }
__device__ __forceinline__ void df_block(const LAS unsigned char* kb, const LAS unsigned char* qb, int c0, int xr, const LAS unsigned char* vb, int vc0, int vx,
                                         bool band, int qpos, int kvb, int hi, const LAS float* btab, float& m_run, float& l_run, f32x16 (&O)[4]) {
    f32x16 p = f32x16{};
#pragma unroll
    for (int ks = 0; ks < 4; ++ks) { const int off = ((c0 + 2 * ks) ^ xr) << 4; const bf16x8 a = *(const LAS bf16x8*)(kb + off); const bf16x8 qq = *(const LAS bf16x8*)(qb + off); p = MFMA32(a, qq, p); }
    __builtin_amdgcn_sched_barrier(0);
    if (band) {
#pragma unroll
        for (int e = 0; e < 16; ++e) { const int rel = qpos - (kvb + swap23(crow(e, 0)) + 8 * hi); const float bb = btab[rel < 0 ? 0 : (rel > 127 ? 127 : rel)]; p[e] = rel < 0 ? -1e30f : p[e] + bb; }
    }
    float mx = fmaxf(p[0], p[1]);
#pragma unroll
    for (int e = 2; e < 16; ++e) mx = fmaxf(mx, p[e]);
    mx = fmaxf(mx, __shfl_xor(mx, 32));
    if (__any(mx > m_run + DF_THR)) {
        const float m_new = fmaxf(m_run, mx), alpha = __builtin_amdgcn_exp2f(m_run - m_new);
        m_run = m_new; l_run *= alpha;
#pragma unroll
        for (int d = 0; d < 4; ++d) O[d] = O[d] * alpha;
    }
    float ps = 0.f;
#pragma unroll
    for (int e = 0; e < 16; ++e) { p[e] = __builtin_amdgcn_exp2f(p[e] - m_run); ps += p[e]; }
    l_run += ps;
    __builtin_amdgcn_sched_barrier(0);
    bf16x8 pk[2];
#pragma unroll
    for (int s = 0; s < 2; ++s) { v4u w; w.x = pk2(p[8 * s + 0], p[8 * s + 1]); w.y = pk2(p[8 * s + 2], p[8 * s + 3]); w.z = pk2(p[8 * s + 4], p[8 * s + 5]); w.w = pk2(p[8 * s + 6], p[8 * s + 7]); pk[s] = __builtin_bit_cast(bf16x8, w); }
#pragma unroll
    for (int d = 0; d < 4; ++d)
#pragma unroll
        for (int s = 0; s < 2; ++s) { const bf16x8 a = *(const LAS bf16x8*)(vb + d * 32 * 128 + (((vc0 + 2 * s) ^ vx) << 4)); O[d] = MFMA32(a, pk[s], O[d]); if (s == 1 && (d & 1)) __builtin_amdgcn_sched_barrier(0); }
}
__device__ __forceinline__ void diff_unit(Frame& F, int b, int h, int qb, int dry) {
    const int lane = F.lane, r = lane & 31, hi = lane >> 5, wid = F.wave;
    const bf16 *QD = act(F, 2), *KD = act(F, 3), *VDT = act(F, 4); bf16* HB = dry ? act(F, 6) : act(F, 2);
    const int qw = qb * 256 + wid * 32, qpos = qw + r;
#ifdef ABL_NOSKIP
    const int ntiles = 4 * (qb + 1), my_last = ntiles - 1, band_first = 0;
#else
    const int ntiles = 4 * (qb + 1), my_last = (qw + 31) >> 6, band_first = (qw - 176) < 0 ? 0 : (qw - 176) >> 6;
#endif
    const LAS float* btab = (const LAS float*)(F.lds + P2_BT);
    const unsigned lds0 = (unsigned)(size_t)F.lds;
    int ln = lane; asm volatile("" : "+v"(ln));
    { const bf16* qsrc = QD + ((size_t)b * SEQ + qw + (ln >> 4)) * 1024 + h * 128; LAS unsigned char* qimg = F.lds + DF_Q0 + wid * 8192 + (ln >> 4) * 256;
#pragma unroll
      for (int j = 0; j < 8; ++j) { const int rr = 4 * j + (ln >> 4), c = ln & 15; const v4u v = *(const GAS v4u*)(qsrc + (size_t)(4 * j) * 1024 + c * 8); *(LAS v4u*)(qimg + j * 1024 + ((c ^ (rr & 15)) << 4)) = v; } }
    const bf16* ksrc[2]; const bf16* vsrc[2];
#pragma unroll
    for (int i = 0; i < 2; ++i) { const int irow = 4 * (2 * wid + i) + (ln >> 4), cs = ln & 15, kv = (irow & 0x30) | swap23(irow & 15);
        ksrc[i] = KD + ((size_t)b * SEQ + kv) * 1024 + h * 128 + ((cs ^ (irow & 15)) << 3);
        const int d = 8 * (2 * wid + i) + (ln >> 3), vs = ln & 7;
        vsrc[i] = VDT + (size_t)(h * 128 + d) * MTOK + (size_t)b * SEQ + ((vs ^ ((d >> 1) & 7)) << 3); }
    const unsigned kdst = lds0 + DF_K0 + 2048 * wid, vdst = lds0 + DF_V0 + 2048 * wid;
#define DF_DMA(t_, buf_) do { _Pragma("unroll") for (int i_ = 0; i_ < 2; ++i_) { \
        glds16(ksrc[i_] + (size_t)(t_) * 64 * 1024, (unsigned)__builtin_amdgcn_readfirstlane(kdst + (buf_) * DF_KBUF + 1024 * i_)); \
        glds16(vsrc[i_] + (t_) * 64, (unsigned)__builtin_amdgcn_readfirstlane(vdst + (buf_) * DF_VBUF + 1024 * i_)); } } while (0)
    f32x16 O1[4], O2[4];
#pragma unroll
    for (int d = 0; d < 4; ++d) { O1[d] = f32x16{}; O2[d] = f32x16{}; }
    float m1 = -1e30f, l1 = 0.f, m2 = -1e30f, l2 = 0.f;
    DF_DMA(0, 0);
    asm volatile("s_waitcnt vmcnt(0)" ::: "memory");
    __syncthreads();
    const int xr = r & 15, vx = (r >> 1) & 7;
    const LAS unsigned char* qimg = F.lds + DF_Q0 + wid * 8192 + r * 256;
    for (int t = 0; t < ntiles; ++t) {
        const int cur = t & 1; const bool more = (t + 1 < ntiles);
        if (more) DF_DMA(t + 1, cur ^ 1);
        if (t <= my_last) {
            const LAS unsigned char* kb = F.lds + DF_K0 + cur * DF_KBUF + r * 256;
            const LAS unsigned char* vb = F.lds + DF_V0 + cur * DF_VBUF + r * 128;
            const bool band = t >= band_first;
            df_block(kb, qimg, hi, xr, vb, hi, vx, band, qpos, t * 64, hi, btab, m1, l1, O1);
            df_block(kb + 32 * 256, qimg, hi, xr, vb, 4 + hi, vx, band, qpos, t * 64 + 32, hi, btab, m1, l1, O1);
            df_block(kb, qimg, 8 + hi, xr, vb, hi, vx, band, qpos, t * 64, hi, btab, m2, l2, O2);
            df_block(kb + 32 * 256, qimg, 8 + hi, xr, vb, 4 + hi, vx, band, qpos, t * 64 + 32, hi, btab, m2, l2, O2);
        }
        asm volatile("s_waitcnt vmcnt(0)" ::: "memory");
        __syncthreads();
    }
#undef DF_DMA
    l1 += __shfl_xor(l1, 32); l2 += __shfl_xor(l2, 32);
    const float lam = *(const LAS float*)(F.lds + P2_LAM), c1 = 1.0f / l1, c2 = lam / l2;
    int ln2 = lane; asm volatile("" : "+v"(ln2)); const int hi2 = ln2 >> 5; const size_t row2 = (size_t)b * SEQ + qw + (ln2 & 31);
    float ss = 0.f;
#pragma unroll
    for (int d = 0; d < 4; ++d)
#pragma unroll
        for (int e = 0; e < 16; ++e) { const float a = O1[d][e] * c1 - O2[d][e] * c2; O1[d][e] = a; ss += a * a; }
    ss += __shfl_xor(ss, 32);
#ifdef ABL_QB
    const float rs = (qb == ABL_QB - 1) ? 0.f : __builtin_amdgcn_rsqf(ss * (1.0f / 128.0f) + LN_EPS) * (1.0f - LAM_INIT);
#else
    const float rs = __builtin_amdgcn_rsqf(ss * (1.0f / 128.0f) + LN_EPS) * (1.0f - LAM_INIT);
#endif
    const LAS float* sg = (const LAS float*)(F.lds + P2_SG);
#pragma unroll
    for (int d = 0; d < 4; ++d)
#pragma unroll
        for (int g = 0; g < 4; ++g) { const int dd = d * 32 + 8 * g + 4 * hi2;
            v2u w; w.x = pk2(O1[d][4 * g] * rs * sg[dd], O1[d][4 * g + 1] * rs * sg[dd + 1]); w.y = pk2(O1[d][4 * g + 2] * rs * sg[dd + 2], O1[d][4 * g + 3] * rs * sg[dd + 3]);
            *(GAS v2u*)(HB + row2 * 1024 + h * 128 + dd) = w; }
}
__device__ __forceinline__ void mem_unit(Frame& F, int b, int hm, int qb) {
    const int lane = F.lane, r = lane & 31, hi = lane >> 5, wid = F.wave;
    const bf16* QM = act(F, 5); bf16* HC = act(F, 6);
    const bf16* KM = (const bf16*)(F.dout + DO_KM); const bf16* VMT = (const bf16*)(F.dout + DO_VMT);
    const size_t row = (size_t)b * SEQ + qb * 256 + wid * 32 + r;
    const bf16* qrow = QM + row * 1024 + hm * 256 + hi * 8;
    const bf16* Kb = KM + (size_t)b * MEML * 1024 + hm * 256;
#pragma unroll 1
    for (int half = 0; half < 2; ++half) {
        const bf16* Vb = VMT + (size_t)(hm * 256 + half * 128) * MMEM + (size_t)b * MEML;
        f32x16 O[4]; float l;
        attn_pass<16, false, false>(F.lds, qrow, Kb, 1024, Vb, MMEM, 4, 3, 4, 0, O, l);
        const float inv = 1.0f / l;
#pragma unroll
        for (int d = 0; d < 4; ++d)
#pragma unroll
            for (int g = 0; g < 4; ++g) { const int dd = d * 32 + 8 * g + 4 * hi;
                v2u w; w.x = pk2(O[d][4 * g] * inv, O[d][4 * g + 1] * inv); w.y = pk2(O[d][4 * g + 2] * inv, O[d][4 * g + 3] * inv);
                *(GAS v2u*)(HC + row * 1024 + hm * 256 + half * 128 + dd) = w; }
    }
}
constexpr int SG_VNT = 0, SG_W = 34816, SG_ST = 69632, SG_ROWB = 272;
__device__ __forceinline__ void sgu_unit(Frame& F, const Args& A, int b, int chunk, int dry) {
    const int tid = F.tid, lane = F.lane, r = lane & 31, hi = lane >> 5, wid = F.wave;
    bf16* U = act(F, 0); const bf16* V = act(F, 1); bf16* HAo = dry ? act(F, 6) : act(F, 0);
    const size_t t0 = (size_t)b * SEQ + chunk * 128;
    const float *lng = A.in[3], *lnb = A.in[4], *wsp = A.in[5], *bsp = A.in[6];
    LAS float* st = (LAS float*)(F.lds + SG_ST);
#pragma unroll 1
    for (int i = 0; i < 16; ++i) { const int s = wid * 16 + i; const bf16* vr = V + (t0 + s) * 1024;
        const v4u a = *(const GAS v4u*)(vr + lane * 8), c = *(const GAS v4u*)(vr + 512 + lane * 8);
        float x[16] = {bflo(a.x), bfhi(a.x), bflo(a.y), bfhi(a.y), bflo(a.z), bfhi(a.z), bflo(a.w), bfhi(a.w), bflo(c.x), bfhi(c.x), bflo(c.y), bfhi(c.y), bflo(c.z), bfhi(c.z), bflo(c.w), bfhi(c.w)};
        float sm = 0.f;
#pragma unroll
        for (int j = 0; j < 16; ++j) sm += x[j];
        const float mean = wave_sum(sm) * (1.0f / 1024.0f); float sq = 0.f;
#pragma unroll
        for (int j = 0; j < 16; ++j) { const float d = x[j] - mean; sq += d * d; }
        const float rstd = __builtin_amdgcn_rsqf(wave_sum(sq) * (1.0f / 1024.0f) + LN_EPS);
        if (lane == 0) { st[2 * s] = mean; st[2 * s + 1] = rstd; } }
    __syncthreads();
#pragma unroll 1
    for (int g = 0; g < 8; ++g) {
#pragma unroll
        for (int i = 0; i < 4; ++i) { const int c = tid + 512 * i, s = c >> 4, part = c & 15; const int ch = g * 128 + part * 8;
            const v4u a = *(const GAS v4u*)(V + (t0 + s) * 1024 + ch); const float mean = st[2 * s], rstd = st[2 * s + 1];
            const f32x4 g0 = *(const GAS f32x4*)(lng + ch), g1 = *(const GAS f32x4*)(lng + ch + 4), b0 = *(const GAS f32x4*)(lnb + ch), b1 = *(const GAS f32x4*)(lnb + ch + 4);
            const float x[8] = {bflo(a.x), bfhi(a.x), bflo(a.y), bfhi(a.y), bflo(a.z), bfhi(a.z), bflo(a.w), bfhi(a.w)};
            const float gg[8] = {g0.x, g0.y, g0.z, g0.w, g1.x, g1.y, g1.z, g1.w}, bb[8] = {b0.x, b0.y, b0.z, b0.w, b1.x, b1.y, b1.z, b1.w};
#pragma unroll
            for (int e = 0; e < 8; ++e) *(LAS unsigned short*)(F.lds + SG_VNT + (part * 8 + e) * SG_ROWB + s * 2) = (unsigned short)f2bf((x[e] - mean) * rstd * gg[e] + bb[e]); }
#pragma unroll
        for (int i = 0; i < 8; ++i) { const int c = tid + 512 * i, t = c >> 5, part = c & 31, s0 = part * 4;
            const f32x4 w = *(const GAS f32x4*)(wsp + ((size_t)g * 128 + t) * 128 + s0);
            v2u o; o.x = pk2(s0 <= t ? w.x : 0.f, s0 + 1 <= t ? w.y : 0.f); o.y = pk2(s0 + 2 <= t ? w.z : 0.f, s0 + 3 <= t ? w.w : 0.f);
            *(LAS v2u*)(F.lds + SG_W + t * SG_ROWB + part * 8) = o; }
        __syncthreads();
        const int dblk = wid >> 1;
        f32x16 acc[2] = {f32x16{}, f32x16{}};
#pragma unroll
        for (int j = 0; j < 2; ++j) { const int tblk = 2 * (wid & 1) + j;
#pragma unroll
#ifdef ABL_NOSKIP
            for (int ks = 0; ks < 8; ++ks) {
#else
            for (int ks = 0; ks < 8; ++ks) if (ks <= 2 * tblk + 1) {
#endif
                const bf16x8 a = *(const LAS bf16x8*)(F.lds + SG_VNT + (dblk * 32 + r) * SG_ROWB + ks * 32 + hi * 16);
                const bf16x8 bq = *(const LAS bf16x8*)(F.lds + SG_W + (tblk * 32 + r) * SG_ROWB + ks * 32 + hi * 16);
                acc[j] = MFMA32(a, bq, acc[j]); } }
#pragma unroll
        for (int j = 0; j < 2; ++j) { const int t = (2 * (wid & 1) + j) * 32 + r; const float bs = bsp[g * 128 + t] * BIASSC; bf16* up = U + (t0 + t) * 1024 + g * 128 + dblk * 32 + 4 * hi;
#pragma unroll
            for (int q = 0; q < 4; ++q) { const v2u uu = *(const GAS v2u*)(up + 8 * q);
                v2u o; o.x = pk2(bflo(uu.x) * (acc[j][4 * q] * MIXSC + bs), bfhi(uu.x) * (acc[j][4 * q + 1] * MIXSC + bs)); o.y = pk2(bflo(uu.y) * (acc[j][4 * q + 2] * MIXSC + bs), bfhi(uu.y) * (acc[j][4 * q + 3] * MIXSC + bs));
                *(GAS v2u*)(HAo + (up - U) + 8 * q) = o; } }
        __syncthreads();
    }
}
__device__ __forceinline__ int t5_bucket(int n) {
    if (n < 16) return n;
    int l = 16 + (int)(logf((float)n / 16.0f) / 2.0794415416798357f * 16.0f);
    return l < 31 ? l : 31;
}
__device__ __forceinline__ void p2_phase(Frame& F, const Args& A, int dry) {
    {
        LAS float* bt = (LAS float*)(F.lds + P2_BT); LAS float* sg = (LAS float*)(F.lds + P2_SG); LAS float* lm = (LAS float*)(F.lds + P2_LAM);
        if (F.tid < 128) sg[F.tid] = A.in[11][F.tid];
        if (F.wave == 2) { const float a = wave_sum(A.in[7][F.lane] * A.in[8][F.lane]), c = wave_sum(A.in[9][F.lane] * A.in[10][F.lane]); if (F.lane == 0) lm[0] = expf(a) - expf(c) + LAM_INIT; }
    }
    __syncthreads();
    for (int v = F.vcu; v < 256; v += F.G) {
        const int x = v >> 5, w = v & 31;
#pragma unroll 1
        for (int rd = 0; rd < 4; ++rd) {
            const int bh = 16 * x + 4 * rd + (w >> 3), qb = (rd & 1) ? 7 - (w & 7) : (w & 7), b = bh >> 3, h = bh & 7;
            { LAS float* bt = (LAS float*)(F.lds + P2_BT); const float* tab = A.in[12];
              if (F.tid < 128) bt[F.tid] = (tab[t5_bucket(F.tid) * 8 + h] - tab[31 * 8 + h]) * LOG2E; }
            __syncthreads();
            if (!dry || (DRYMASK & 1)) diff_unit(F, b, h, qb, dry);
        }
    }
    for (int v = F.vcu; v < 256; v += F.G) {
#pragma unroll 1
        for (int i = 0; i < 2; ++i) { const int id = 2 * v + i;
#ifndef ONLY_DIFF
            if (!dry || (DRYMASK & 2)) mem_unit(F, id >> 5, (id >> 3) & 3, id & 7);
#endif
        }
    }
#ifndef ONLY_DIFF
    if (!dry || (DRYMASK & 4)) for (int v = F.vcu; v < 256; v += F.G) sgu_unit(F, A, v >> 4, v & 15, dry);
#endif
}

__device__ __forceinline__ void ln1_rows(Frame& F, const Args& A) {
    const int gw = F.vcu * NWAVES + F.wave, NGW = F.G * NWAVES;
    float* R = (float*)F.dout; bf16* X1B = act(F, 0); const float *g = A.in[18], *bb = A.in[19];
    f32x4 gv[4], bv[4];
#pragma unroll
    for (int j = 0; j < 4; ++j) { gv[j] = *(const GAS f32x4*)(g + 4 * F.lane + 256 * j); bv[j] = *(const GAS f32x4*)(bb + 4 * F.lane + 256 * j); }
    for (int m = gw; m < MTOK; m += NGW) {
        GAS f32x4* xr = (GAS f32x4*)(R + (size_t)m * 1024) + F.lane;
        f32x4 v[4]; float s = 0.f;
#pragma unroll
        for (int j = 0; j < 4; ++j) { v[j] = xr[64 * j]; s += (v[j].x + v[j].y) + (v[j].z + v[j].w); }
        const float mean = wave_sum(s) * (1.f / 1024.f); float s2 = 0.f;
#pragma unroll
        for (int j = 0; j < 4; ++j) { v[j] = v[j] - mean; s2 += (v[j].x * v[j].x + v[j].y * v[j].y) + (v[j].z * v[j].z + v[j].w * v[j].w); }
        const float rstd = __builtin_amdgcn_rsqf(wave_sum(s2) * (1.f / 1024.f) + LN_EPS);
        GAS v2u* o8 = (GAS v2u*)(X1B + (size_t)m * 1024) + F.lane;
#pragma unroll
        for (int j = 0; j < 4; ++j) { const f32x4 y = v[j] * rstd * gv[j] + bv[j]; xr[64 * j] = y; v2u w; w.x = pk2(y.x, y.y); w.y = pk2(y.z, y.w); o8[64 * j] = w; }
    }
}

constexpr int TK_ROWB = 528;
#define MED3(a, b, c) __builtin_amdgcn_fmed3f((a), (b), (c))
__device__ __forceinline__ void topk_phase(Frame& F) {
    const int lane = F.lane, p = lane & 31, half = lane >> 5;
    const int gw = F.vcu * NWAVES + F.wave, NGW = F.G * NWAVES;
    LAS unsigned char* tile = F.lds + RING_OFF + F.wave * (32 * TK_ROWB);
    int* IDX = (int*)(F.ws + WS_A0 + 3 * ACT_BYTES); float* GATE = (float*)(F.ws + WS_A0 + 3 * ACT_BYTES + 16 * MiB);
    for (int it = gw; it < (MTOK / 32) * 8; it += NGW) {
        const int h = it & 7, t0 = (it >> 3) * 32;
        const bf16* S = act(F, h < 4 ? 2 : 5) + (size_t)t0 * 1024 + (h & 3) * 256;
#pragma unroll
        for (int i = 0; i < 16; ++i) { const int row = 2 * i + half; const v4u v = *(const GAS v4u*)(S + (size_t)row * 1024 + p * 8); *(LAS v4u*)(tile + row * TK_ROWB + p * 16) = v; }
        LDS_WAIT(); asm volatile("" ::: "memory");
        float L[16];
#pragma unroll
        for (int i = 0; i < 16; ++i) L[i] = -INFINITY;
        const LAS unsigned char* myrow = tile + p * TK_ROWB + half * 256;
#pragma unroll 2
        for (int j = 0; j < 16; ++j) {
            const v4u w = *(const LAS v4u*)(myrow + j * 16);
            const unsigned ww[4] = {w.x, w.y, w.z, w.w};
#pragma unroll
            for (int e = 0; e < 8; ++e) {
                const unsigned bits = ((e & 1) ? (ww[e >> 1] & 0xffff0000u) : (ww[e >> 1] << 16)) | (unsigned)(j * 8 + e);
                const float v = __uint_as_float(bits);
#pragma unroll
                for (int i = 15; i >= 1; --i) L[i] = MED3(L[i - 1], L[i], v);
                L[0] = fmaxf(L[0], v);
            }
        }
        float A[16], Bv[16];
#pragma unroll
        for (int i = 0; i < 16; ++i) { const float o = __shfl_xor(L[i], 32); A[i] = half ? o : L[i]; Bv[i] = half ? L[i] : o; }
        LAS unsigned* mine = (LAS unsigned*)(tile + p * TK_ROWB + half * 256);
        asm volatile("" ::: "memory");
#pragma unroll
        for (int i = 0; i < 16; ++i) { mine[i] = __float_as_uint(A[i]) & 0x7fu; mine[16 + i] = __float_as_uint(Bv[i]) & 0x7fu; }
        float T[16];
#pragma unroll
        for (int i = 0; i < 16; ++i) T[i] = -INFINITY;
#pragma unroll
        for (int i = 0; i < 16; ++i)
#pragma unroll
            for (int j = 0; j < 16; ++j) if ((i + 1) * (j + 1) <= 16) {
                const float sum = __uint_as_float(__float_as_uint(A[i]) & 0xffff0000u) + __uint_as_float(__float_as_uint(Bv[j]) & 0xffff0000u);
                const float v = __uint_as_float((__float_as_uint(sum) & 0xffffff00u) | (unsigned)(i * 16 + j));
#pragma unroll
                for (int q = 15; q >= 1; --q) T[q] = MED3(T[q - 1], T[q], v);
                T[0] = fmaxf(T[0], v);
            }
        float e[16], den = 0.f; const float mxs = __uint_as_float(__float_as_uint(T[0]) & 0xffffff00u);
#pragma unroll
        for (int q = 0; q < 16; ++q) { e[q] = __expf(__uint_as_float(__float_as_uint(T[q]) & 0xffffff00u) - mxs); den += e[q]; }
        const float inv = 1.0f / den;
        LDS_WAIT(); asm volatile("" ::: "memory");
        int id8[8]; float g8[8];
#pragma unroll
        for (int q = 0; q < 8; ++q) {
            const float tv = half ? T[8 + q] : T[q]; const unsigned code = __float_as_uint(tv) & 0xffu;
            id8[q] = (int)(mine[code >> 4] * 128u + mine[16 + (code & 15u)]); g8[q] = (half ? e[8 + q] : e[q]) * inv;
        }
        const size_t o = (size_t)(t0 + p) * 128 + h * 16 + half * 8;
        *(GAS v4u*)(IDX + o) = (v4u){(unsigned)id8[0], (unsigned)id8[1], (unsigned)id8[2], (unsigned)id8[3]}; *(GAS v4u*)(IDX + o + 4) = (v4u){(unsigned)id8[4], (unsigned)id8[5], (unsigned)id8[6], (unsigned)id8[7]};
        *(GAS f32x4*)(GATE + o) = (f32x4){g8[0], g8[1], g8[2], g8[3]}; *(GAS f32x4*)(GATE + o + 4) = (f32x4){g8[4], g8[5], g8[6], g8[7]};
        LDS_WAIT(); asm volatile("" ::: "memory");
    }
}

__device__ __forceinline__ void fp8x16_to_f32(const v4u& a, float (&f)[16]) {
#pragma unroll
    for (int j = 0; j < 4; ++j) { const f32x2_t lo = __builtin_amdgcn_cvt_pk_f32_fp8((int)a[j], false), hi = __builtin_amdgcn_cvt_pk_f32_fp8((int)a[j], true);
        f[4 * j] = lo.x; f[4 * j + 1] = lo.y; f[4 * j + 2] = hi.x; f[4 * j + 3] = hi.y; }
}
__device__ __forceinline__ void peer_phase(Frame& F, const Args& A, int dry) {
    const int lane = F.lane;
    const int gw = F.vcu * NWAVES + F.wave, NGW = F.G * NWAVES;
    const int* IDX = (const int*)(F.ws + WS_A0 + 3 * ACT_BYTES); const float* GATE = (const float*)(F.ws + WS_A0 + 3 * ACT_BYTES + 16 * MiB);
    const unsigned char* PU8 = (const unsigned char*)act(F, 1); const unsigned char* PV8 = PU8 + 16 * MiB; const float* PUS = (const float*)(PU8 + 32 * MiB); const float* PVS = PUS + NEXP;
    float* X1 = (float*)F.dout; const float *g2 = A.in[24], *b2 = A.in[25];
    for (int m = gw; m < MTOK; m += NGW) {
        const int id0 = IDX[(size_t)m * 128 + lane], id1 = IDX[(size_t)m * 128 + 64 + lane];
        const float ga0 = GATE[(size_t)m * 128 + lane], ga1 = GATE[(size_t)m * 128 + 64 + lane];
        const float su0 = PUS[id0], su1 = PUS[id1], sv0 = PVS[id0], sv1 = PVS[id1];
        float* xr = X1 + (size_t)m * 1024 + 16 * lane;
        float x[16];
#pragma unroll
        for (int j = 0; j < 4; ++j) { const f32x4 t = *(const GAS f32x4*)(xr + 4 * j); x[4 * j] = t.x; x[4 * j + 1] = t.y; x[4 * j + 2] = t.z; x[4 * j + 3] = t.w; }
#define PEER_LOADG(buf, tab, idv, l0) do { _Pragma("unroll") for (int e_ = 0; e_ < 8; ++e_) { const int row_ = __builtin_amdgcn_readlane((idv), (l0) + e_); buf[e_] = *(const GAS v4u*)((tab) + (size_t)row_ * 1024 + 16 * lane); } } while (0)
#define PEER_DOTG(buf, o0) do { _Pragma("unroll") for (int e_ = 0; e_ < 8; ++e_) { float f_[16]; fp8x16_to_f32(buf[e_], f_); \
            float s0_ = x[0] * f_[0], s1_ = x[1] * f_[1], s2_ = x[2] * f_[2], s3_ = x[3] * f_[3]; \
            _Pragma("unroll") for (int j_ = 1; j_ < 4; ++j_) { s0_ += x[4 * j_] * f_[4 * j_]; s1_ += x[4 * j_ + 1] * f_[4 * j_ + 1]; s2_ += x[4 * j_ + 2] * f_[4 * j_ + 2]; s3_ += x[4 * j_ + 3] * f_[4 * j_ + 3]; } \
            pr[(o0) + e_] = (s0_ + s1_) + (s2_ + s3_); } __builtin_amdgcn_sched_barrier(0); } while (0)
#define PEER_AXPYG(buf, wv_, l0) do { _Pragma("unroll") for (int e_ = 0; e_ < 8; ++e_) { const float w_ = __builtin_bit_cast(float, __builtin_amdgcn_readlane(__builtin_bit_cast(int, (wv_)), (l0) + e_)); \
            float f_[16]; fp8x16_to_f32(buf[e_], f_); _Pragma("unroll") for (int j_ = 0; j_ < 16; ++j_) y[j_] += w_ * f_[j_]; } __builtin_amdgcn_sched_barrier(0); } while (0)
        v4u b0[8], b1[8];
        float d01 = 0.f, d23 = 0.f;
        PEER_LOADG(b0, PU8, id0, 0);
#pragma unroll 1
        for (int blk = 0; blk < 4; ++blk) {
            const int idv = blk < 2 ? id0 : id1, l0 = (blk & 1) * 32;
            float pr[32];
            PEER_LOADG(b1, PU8, idv, l0 + 8);  __builtin_amdgcn_sched_barrier(0);
            PEER_DOTG(b0, 0);
            PEER_LOADG(b0, PU8, idv, l0 + 16); __builtin_amdgcn_sched_barrier(0);
            PEER_DOTG(b1, 8);
            PEER_LOADG(b1, PU8, idv, l0 + 24); __builtin_amdgcn_sched_barrier(0);
            PEER_DOTG(b0, 16);
            if (blk < 3) { const int idn = blk < 1 ? id0 : id1, ln = ((blk + 1) & 1) * 32; PEER_LOADG(b0, PU8, idn, ln); }
            else PEER_LOADG(b0, PV8, id0, 0);
            __builtin_amdgcn_sched_barrier(0);
            PEER_DOTG(b1, 24);
#pragma unroll
            for (int s = 16; s >= 1; s >>= 1) {
                const bool up = (lane & s) != 0;
#pragma unroll
                for (int i = 0; i < s; ++i) { const float lo = pr[i], hv = pr[i + s]; const float send = up ? lo : hv, keep = up ? hv : lo; pr[i] = keep + __shfl_xor(send, s); }
            }
            const float d = pr[0] + __shfl_xor(pr[0], 32); const bool mine = (lane >> 5) == (blk & 1);
            if (blk < 2) d01 = mine ? d : d01; else d23 = mine ? d : d23;
        }
        const float wg0 = ga0 * gelu1(d01 * su0) * sv0;
        const float wg1 = ga1 * gelu1(d23 * su1) * sv1;
        float y[16];
#pragma unroll
        for (int j = 0; j < 16; ++j) y[j] = 0.f;
#pragma unroll 1
        for (int gg = 0; gg < 8; ++gg) {
            const int ida = gg < 4 ? id0 : id1; const float wa = gg < 4 ? wg0 : wg1; const int la = (gg & 3) * 16;
            PEER_LOADG(b1, PV8, ida, la + 8); __builtin_amdgcn_sched_barrier(0);
            PEER_AXPYG(b0, wa, la);
            if (gg < 7) { const int idb = gg < 3 ? id0 : id1, lb = ((gg + 1) & 3) * 16; PEER_LOADG(b0, PV8, idb, lb); }
            __builtin_amdgcn_sched_barrier(0);
            PEER_AXPYG(b1, wa, la + 8);
        }
#undef PEER_LOADG
#undef PEER_DOTG
#undef PEER_AXPYG
        f32x4 v[4]; float s = 0.f;
#pragma unroll
        for (int j = 0; j < 4; ++j) { v[j] = (f32x4){x[4 * j], x[4 * j + 1], x[4 * j + 2], x[4 * j + 3]} * ALPHA + (f32x4){y[4 * j], y[4 * j + 1], y[4 * j + 2], y[4 * j + 3]} * (ABL_PEER == 1 ? 0.f : ABL_PEER == 2 ? 0.5f : ABL_PEER == 3 ? 2.f : 1.f); s += (v[j].x + v[j].y) + (v[j].z + v[j].w); }
        const float mean = wave_sum(s) * (1.f / 1024.f); float s2 = 0.f;
#pragma unroll
        for (int j = 0; j < 4; ++j) { v[j] = v[j] - mean; s2 += (v[j].x * v[j].x + v[j].y * v[j].y) + (v[j].z * v[j].z + v[j].w * v[j].w); }
        const float rstd = __builtin_amdgcn_rsqf(wave_sum(s2) * (1.f / 1024.f) + LN_EPS);
        float* orow = (dry ? (float*)act(F, 5) + (size_t)m * 1024 : X1 + (size_t)m * 1024) + 16 * lane;
#pragma unroll
        for (int j = 0; j < 4; ++j) { const f32x4 gg = *(const GAS f32x4*)(g2 + 16 * lane + 4 * j), bb = *(const GAS f32x4*)(b2 + 16 * lane + 4 * j);
            *(GAS f32x4*)(orow + 4 * j) = v[j] * rstd * gg + bb; }
    }
}

__global__ void __launch_bounds__(NWAVES * 64, 2) mk_fwd(Args A) {
    extern __shared__ __attribute__((aligned(16))) unsigned char lds[];
    Frame F;
    F.lds = (LAS unsigned char*)lds;
    F.MISC = (volatile LAS unsigned*)(F.lds + MISC_OFF);
    F.tid = threadIdx.x; F.lane = F.tid & 63; F.wave = __builtin_amdgcn_readfirstlane(F.tid >> 6);
    F.G = gridDim.x; { const int bx = blockIdx.x; F.vcu = (F.G % 8 == 0) ? (bx % 8) * (F.G / 8) + bx / 8 : bx; }
    F.ws = A.ws; F.dout = (unsigned char*)A.out; F.ctl = (gu32*)(A.ws + WS_CTL);
    for (int u = F.tid; u < (LDS_BYTES - LDSCTL_OFF) / 4; u += NWAVES * 64) ((LAS unsigned*)(F.lds + LDSCTL_OFF))[u] = 0u;
    __syncthreads();
    XcdBarrier bar; bar.bar = (unsigned*)(F.ctl + CW_BAR); bar.x = 0; bar.st = nullptr;
    if (N_LAUNCHES != PER_PHASE) bar = xcd_barrier_post((unsigned*)(F.ctl + CW_BAR), F.MISC + 8);
#define GRID_BAR() do { if (N_LAUNCHES != PER_PHASE) xcd_barrier(bar); } while (0)
#ifdef TSTAMP
    unsigned long long* tsb = (unsigned long long*)(A.ws + 131072); int nst = 0;
#define STAMP() do { if (blockIdx.x == 0 && F.tid == 0) tsb[nst] = __builtin_amdgcn_s_memrealtime(); ++nst; } while (0)
    STAMP();
#else
#define STAMP() do {} while (0)
#endif
#ifndef REPEAT_PH
#define REPEAT_PH -1
#endif

    const int lo = A.ph_lo, hi = A.ph_hi;
#ifndef MK_PHASE_MASK
#define MK_PHASE_MASK 0x3ff
#endif
#define IN(k) (((MK_PHASE_MASK >> (k)) & 1) && lo <= (k) && (k) < hi)
#define BOTH(k) (IN(k) && IN((k) + 1))
    const bf16* XB = (const bf16*)(F.dout + DO_XB);

    if (IN(0)) { p0_prologue(F, A); if (BOTH(0)) GRID_BAR(); STAMP(); }

    if (IN(1)) {
        { pg8::Gemm g{XB, wsb(F, WS_WVDT), (const bf16*)(F.dout + DO_MEMB), wsb(F, WS_WMVT), wsb(F, WS_W1T), XB, wsb(F, WS_WMKT), (const bf16*)(F.dout + DO_MEMB), 1024};
          pg8::MultiOrder S; S.init(F.G, (int)blockIdx.x, 128, 20, 4, 128, 16, 4, 4, 16);
          pg8::EpiP1 E{act(F, 0), act(F, 1), act(F, 2), act(F, 3), act(F, 5), act(F, 4), (bf16*)(F.dout + DO_KM), (bf16*)(F.dout + DO_VMT)};
          pg8::gemm_phase<pg8::EpiP1, pg8::MultiOrder, true, true>(F.lds + RING_OFF, g, S, E); }
        { pg8::Gemm g{wsb(F, WS_SKD), nullptr, nullptr, nullptr, wsb(F, WS_WPQ), nullptr, nullptr, nullptr, 2048};
          pg8::MultiOrder S; S.init(F.G, (int)blockIdx.x, 8, 4);
          pg8::EpiPlain E{wsb(F, WS_WST), 1024};
          pg8::gemm_phase<pg8::EpiPlain, pg8::MultiOrder, true, true>(F.lds + RING_OFF, g, S, E); }
        if (BOTH(1)) GRID_BAR(); STAMP();
    }

    if (IN(2)) { p2_phase(F, A, A.pad); if (BOTH(2)) GRID_BAR(); STAMP(); }

    if (IN(3)) {
        pg8::Gemm g{XB, nullptr, nullptr, nullptr, wsb(F, WS_WGT), nullptr, nullptr, nullptr, 1024};
        pg8::MultiOrder S; S.init(F.G, (int)blockIdx.x, 128, 12);
#ifdef SWAPG
        pg8::EpiSplit<3> E{act(F, 3), act(F, 1), act(F, 4), A.in[15]};
#else
        pg8::EpiSplit<3> E{act(F, 1), act(F, 3), act(F, 4), A.in[15]};
#endif
        pg8::gemm_phase<pg8::EpiSplit<3>, pg8::MultiOrder, true, true>(F.lds + RING_OFF, g, S, E);
        if (BOTH(3)) GRID_BAR(); STAMP();
    }

    if (IN(4)) {
        pg8::Gemm g{act(F, 0), act(F, 2), act(F, 6), nullptr, wsb(F, WS_WBT), wsb(F, WS_WBT) + (size_t)1024 * 1024, wsb(F, WS_WBT) + (size_t)2 * 1024 * 1024, nullptr, 1024};
        pg8::MultiOrder S; S.init(F.G, (int)blockIdx.x, 128, 4, 128, 4, 128, 4);
        pg8::EpiMerge E{act(F, 5), act(F, 1), act(F, 3), act(F, 4)};
        pg8::gemm_phase<pg8::EpiMerge, pg8::MultiOrder, true, true>(F.lds + RING_OFF, g, S, E);
        if (BOTH(4)) GRID_BAR(); STAMP();
    }

    if (IN(5)) {
        pg8::Gemm g{act(F, 5), nullptr, nullptr, nullptr, wsb(F, WS_WOT), nullptr, nullptr, nullptr, 1024};
        pg8::MultiOrder S; S.init(F.G, (int)blockIdx.x, 128, 4);
        pg8::EpiResid E{A.in[0], (float*)F.dout, ALPHA};
        pg8::gemm_phase<pg8::EpiResid, pg8::MultiOrder, true, true>(F.lds + RING_OFF, g, S, E);
        const int gw = F.vcu * NWAVES + F.wave, NGW = F.G * NWAVES;
        unsigned char* P8 = (unsigned char*)act(F, 1); float* PS = (float*)(P8 + 32 * MiB);
        for (int m = gw; m < 2 * NEXP; m += NGW) cvt_row_fp8((m < NEXP ? A.in[22] : A.in[23] - (size_t)NEXP * 1024) + (size_t)m * 1024, P8 + (size_t)m * 1024, PS + m, F.lane);
        if (BOTH(5)) GRID_BAR(); STAMP();
    }

    if (IN(6)) { ln1_rows(F, A); if (BOTH(6)) GRID_BAR(); STAMP(); }

    if (IN(7)) {
        pg8::Gemm g{act(F, 0), nullptr, nullptr, nullptr, wsb(F, WS_WST), nullptr, nullptr, nullptr, 1024};
        pg8::MultiOrder S; S.init(F.G, (int)blockIdx.x, 128, 8);
        pg8::EpiSplit<0> E{act(F, 2), act(F, 5), act(F, 5), A.in[15]};
        pg8::gemm_phase<pg8::EpiSplit<0>, pg8::MultiOrder, true, true>(F.lds + RING_OFF, g, S, E);
        if (BOTH(7)) GRID_BAR(); STAMP();
    }

    if (IN(8)) { topk_phase(F); if (BOTH(8)) GRID_BAR(); STAMP(); }

    if (IN(9)) { peer_phase(F, A, A.pad); STAMP(); }
#undef IN
#undef BOTH
}


#ifdef TSTAMP
__global__ void __launch_bounds__(256) ts_encode(float* out, const unsigned long long* ts, int k) {
    const float us = (float)(ts[k + 1] - ts[k]) * 0.01f; const float C = sqrtf(us);
    for (size_t i = (size_t)blockIdx.x * blockDim.x + threadIdx.x; i < (size_t)MTOK * DM; i += (size_t)gridDim.x * blockDim.x) out[i] = C;
}
#endif
extern "C" void kernel_launch(void* const* d_in, const int* in_sizes, int n_in, void* d_out, int out_size, void* d_ws, size_t ws_size, hipStream_t stream) {
    static int grid = 0;
    if (grid == 0) {
        if (n_in != 26 || in_sizes[0] != MTOK * DM || out_size != MTOK * DM || ws_size < WS_END) {
            fprintf(stderr, "kernel_launch: unexpected shapes (n_in %d, in0 %d, out %d, ws %zu; need ws >= %zu); nothing launched\n", n_in, n_in > 0 ? in_sizes[0] : -1, out_size, ws_size, (size_t)WS_END); grid = -1; return; }
        int dev = 0, cus = 0, per_cu = 0;
        if (hipGetDevice(&dev) != hipSuccess || hipDeviceGetAttribute(&cus, hipDeviceAttributeMultiprocessorCount, dev) != hipSuccess) { fprintf(stderr, "kernel_launch: device query failed\n"); grid = -1; return; }
        if (hipFuncSetAttribute((const void*)mk_fwd, hipFuncAttributeMaxDynamicSharedMemorySize, LDS_BYTES) != hipSuccess) { fprintf(stderr, "kernel_launch: hipFuncSetAttribute failed\n"); grid = -1; return; }
        if (hipOccupancyMaxActiveBlocksPerMultiprocessor(&per_cu, (const void*)mk_fwd, NWAVES * 64, LDS_BYTES) != hipSuccess || per_cu < 1) { fprintf(stderr, "kernel_launch: occupancy query reports %d workgroups per CU\n", per_cu); }
        (void)hipGetLastError();
        grid = cus;
    }
    if (grid < 0) return;
    if (hipMemsetAsync((char*)d_ws + WS_CTL, 0, CTL_ZERO_BYTES, stream) != hipSuccess) { fprintf(stderr, "kernel_launch: hipMemsetAsync failed\n"); return; }
    Args a{};
    for (int i = 0; i < 26; ++i) a.in[i] = (const float*)d_in[i];
    a.out = (float*)d_out; a.ws = (unsigned char*)d_ws;
#ifdef ABL_TWICE
    for (int rep = 0; rep < 2; ++rep) {
    if (rep) (void)hipMemsetAsync((char*)d_ws + WS_CTL, 0, CTL_ZERO_BYTES, stream);
#endif
#ifdef DBG
    {
        constexpr int last_phase = DBG == 1 ? 1 : DBG <= 4 ? 2 : DBG == 5 ? 3 : DBG == 6 ? 4 : DBG == 7 ? 5 : DBG == 8 ? 6 : DBG == 9 ? 7 : DBG == 10 ? 8 : 9;
        for (int li = 0; li <= last_phase; ++li) { a.ph_lo = li; a.ph_hi = li + 1; a.li = li; hipLaunchKernelGGL(mk_fwd, dim3(grid), dim3(NWAVES * 64), LDS_BYTES, stream, a); }
        DbgP P{}; for (int i = 0; i < 26; ++i) P.in[i] = (const float*)d_in[i]; P.ws = (unsigned char*)d_ws; P.dout = (unsigned char*)d_out; P.st = (float*)((char*)d_ws + 65536);
        if (DBG == 1) hipLaunchKernelGGL(chk_p1, dim3(375), dim3(256), 0, stream, P);
        if (DBG == 2) hipLaunchKernelGGL(chk_sgu, dim3(512), dim3(128), 0, stream, P);
        if (DBG == 3) hipLaunchKernelGGL(chk_diff, dim3(600), dim3(256), 0, stream, P);
        if (DBG == 4) hipLaunchKernelGGL(chk_mem, dim3(400), dim3(256), 0, stream, P);
        if (DBG == 5 || DBG == 6 || DBG == 7 || DBG == 9) hipLaunchKernelGGL(chk_gemm, dim3(150), dim3(256), 0, stream, P, (int)DBG);
        if (DBG == 8) hipLaunchKernelGGL(chk_ln1, dim3(128), dim3(256), 0, stream, P);
        if (DBG == 10) hipLaunchKernelGGL(chk_topk, dim3(16), dim3(256), 0, stream, P);
        if (DBG == 11) hipLaunchKernelGGL(chk_final, dim3(300), dim3(256), 0, stream, P);
        hipLaunchKernelGGL(dbg_encode, dim3(2048), dim3(256), 0, stream, (float*)d_out, (const float*)P.st, (int)DBG_PAIR);
        return;
    }
#endif
    const int nl = (N_LAUNCHES == PER_PHASE) ? PER_PHASE : 1;
    for (int li = 0; li < nl; ++li) {
        a.ph_lo = (N_LAUNCHES == PER_PHASE) ? li : 0; a.ph_hi = (N_LAUNCHES == PER_PHASE) ? li + 1 : PER_PHASE; a.li = li;
        if (N_LAUNCHES == PER_PHASE && li == REPEAT_PH) { a.pad = 1; hipLaunchKernelGGL(mk_fwd, dim3(grid), dim3(NWAVES * 64), LDS_BYTES, stream, a); a.pad = 0; }
        hipLaunchKernelGGL(mk_fwd, dim3(grid), dim3(NWAVES * 64), LDS_BYTES, stream, a);
        const hipError_t le = hipPeekAtLastError();
        if (le != hipSuccess) { fprintf(stderr, "kernel_launch: launch %d failed: %s\n", li, hipGetErrorName(le)); break; }
    }
#ifdef TSTAMP
    hipLaunchKernelGGL(ts_encode, dim3(2048), dim3(256), 0, stream, (float*)d_out, (const unsigned long long*)((char*)d_ws + 131072), (int)TSTAMP);
#endif
#ifdef ABL_TWICE
    }
#endif
}
```

```cpp
#include <hip/hip_runtime.h>
#include <cstdio>
#include <cstdint>
#include <cmath>

#ifndef SC_A
#define SC_A 1.f
#endif
#ifndef SC_B
#define SC_B 1.f
#endif
#ifndef SC_C
#define SC_C 1.f
#endif
#ifndef ABL_BR
#define ABL_BR 0
#endif
#ifndef ABL_PEER
#define ABL_PEER 0
#endif
#ifndef ABL_Y
#define ABL_Y 0
#endif
#ifdef DBG
#define MK_N_LAUNCHES 10
#ifndef DBG_PAIR
#define DBG_PAIR 0
#endif
#endif
#ifndef MK_N_LAUNCHES
#define MK_N_LAUNCHES 1
#endif

namespace pg8 {
#define PG8_LAS __attribute__((address_space(3)))
typedef unsigned short bf16_t;
typedef short bf16x8 __attribute__((ext_vector_type(8)));
typedef float f32x4 __attribute__((ext_vector_type(4)));
typedef unsigned u32x4 __attribute__((ext_vector_type(4)));
typedef unsigned u32x2 __attribute__((ext_vector_type(2)));
constexpr int BM = 256, BK = 64, HALF = 128, HTB = HALF * BK * 2  , STAGE_BYTES = 8 * HTB, NXCD = 8, WGM = 8;

__host__ __device__ __forceinline__ int lds_byte(int r, int c) { const int st = (r >> 4) * 2 + (c >> 5), rr = r & 15, cc = c & 31, ob = rr * 64 + cc * 2; return st * 1024 + (ob ^ (((ob >> 9) & 1) << 5)); }
__host__ __device__ __forceinline__ void stage_rc(int b, int& R, int& C) { const int st = b / 1024, sb = b % 1024, swz = sb ^ (((sb >> 9) & 1) << 5); R = (st >> 1) * 16 + swz / 64; C = (st & 1) * 32 + (swz % 64) / 2; }
__host__ __device__ __forceinline__ int perm32(int rho) { const int n = rho >> 4, i = rho & 15; return 8 * (i >> 2) + 4 * n + (i & 3); }

struct Unit { int pm, pn, job; };
struct Gemm { const bf16_t *A0, *A1, *A2, *A3; const bf16_t *B0, *B1, *B2, *B3; int K; };
__device__ __forceinline__ const char* jobA(const Gemm& g, int j) { return (const char*)(j == 0 ? g.A0 : j == 1 ? g.A1 : j == 2 ? g.A2 : g.A3); }
__device__ __forceinline__ const char* jobB(const Gemm& g, int j) { return (const char*)(j == 0 ? g.B0 : j == 1 ? g.B1 : j == 2 ? g.B2 : g.B3); }

struct MultiOrder {
    int nM0, nN0, nM1, nN1, nM2, nN2, nM3, nN3, s1, s2, s3, s4, G, c;
    __device__ void init(int G_, int c_, int m0, int n0, int m1 = 0, int n1 = 0, int m2 = 0, int n2 = 0, int m3 = 0, int n3 = 0) {
        nM0 = m0; nN0 = n0; nM1 = m1; nN1 = n1; nM2 = m2; nN2 = n2; nM3 = m3; nN3 = n3; s1 = m0 * n0; s2 = s1 + m1 * n1; s3 = s2 + m2 * n2; s4 = s3 + m3 * n3; G = G_; c = c_; }
    __device__ bool next(int i, Unit& u) const {
        const long L = (long)i * G + c; if (L >= s4) return false;
        int nM, nN, loc;
        if (L < s1) { u.job = 0; nM = nM0; nN = nN0; loc = (int)L; }
        else if (L < s2) { u.job = 1; nM = nM1; nN = nN1; loc = (int)L - s1; }
        else if (L < s3) { u.job = 2; nM = nM2; nN = nN2; loc = (int)L - s2; }
        else { u.job = 3; nM = nM3; nN = nN3; loc = (int)L - s3; }
        const int nwg = nM * nN; int wgid = loc; { const int q = nwg / NXCD, r = nwg % NXCD, xcd = wgid % NXCD, off = wgid / NXCD; wgid = (xcd < r ? xcd * (q + 1) : r * (q + 1) + (xcd - r) * q) + off; }
        const int nig = WGM * nN, gid = wgid / nig, fm = gid * WGM, gsz = (nM - fm) < WGM ? (nM - fm) : WGM;
        u.pm = fm + ((wgid % nig) % gsz); u.pn = (wgid % nig) / gsz; return true;
    }
    __device__ __forceinline__ void a_ready(const Unit&) const {}
    __device__ __forceinline__ void done(const Unit&) const {}
};

typedef float f32x2 __attribute__((ext_vector_type(2)));
typedef __bf16 bf16x2v __attribute__((ext_vector_type(2)));
__device__ __forceinline__ unsigned cvt_pk_bf16(float lo, float hi) { f32x2 v = {lo, hi}; bf16x2v b = __builtin_convertvector(v, bf16x2v); return __builtin_bit_cast(unsigned, b); }
__device__ __forceinline__ f32x2 gelu_pk(f32x2 v) {
    const f32x2 av = __builtin_elementwise_abs(v), d = av * 0.2316418882f + 1.0f;
    f32x2 t; t.x = __builtin_amdgcn_rcpf(d.x); t.y = __builtin_amdgcn_rcpf(d.y);
    f32x2 q = t * 0.5307027145f + (-0.7265760135f); q = q * t + 0.7107068705f; q = q * t + (-0.142248368f); q = q * t + 0.127414796f; q = q * t;
    const f32x2 s = (v * v) * (-0.72134752044f);
    f32x2 e; e.x = __builtin_amdgcn_exp2f(s.x); e.y = __builtin_amdgcn_exp2f(s.y);
    const f32x2 m = v * (q * e), r = v - m;
    f32x2 o; o.x = v.x < 0.f ? m.x : r.x; o.y = v.y < 0.f ? m.y : r.y; return o;
}
__device__ __forceinline__ float bf_lo(unsigned w) { return __uint_as_float(w << 16); }
__device__ __forceinline__ float bf_hi(unsigned w) { return __uint_as_float(w & 0xffff0000u); }
__device__ __forceinline__ float sigmoidf_(float x) { return __builtin_amdgcn_rcpf(1.0f + __builtin_amdgcn_exp2f(-1.4426950408889634f * x)); }

template <int MODE>
__device__ __forceinline__ void store_tile_bf16(const f32x4 (&acc)[2][2][4][2], bf16_t* base, int ldc, int row0, int col0, float sc, const float* bias, const bf16_t* gate) {
    f32x4 bv[2][2];
    if (MODE == 3) {
#pragma unroll
        for (int bj = 0; bj < 2; ++bj)
#pragma unroll
            for (int n = 0; n < 2; ++n) bv[bj][n] = *(const f32x4*)(bias + bj * HALF + 4 * n);
    }
#pragma unroll
    for (int ai = 0; ai < 2; ++ai)
#pragma unroll
        for (int m = 0; m < 4; ++m) { const size_t roff = (size_t)(row0 + ai * HALF + m * 16) * ldc + col0;
#pragma unroll
            for (int bj = 0; bj < 2; ++bj) { f32x4 v0 = acc[ai][bj][m][0], v1 = acc[ai][bj][m][1];
                if (MODE == 1) { f32x2 a = gelu_pk((f32x2){v0[0], v0[1]}), b = gelu_pk((f32x2){v0[2], v0[3]}), c = gelu_pk((f32x2){v1[0], v1[1]}), d = gelu_pk((f32x2){v1[2], v1[3]});
                    v0 = (f32x4){a.x, a.y, b.x, b.y}; v1 = (f32x4){c.x, c.y, d.x, d.y}; }
                if (MODE == 2) { v0 = v0 * sc; v1 = v1 * sc; }
#ifdef ABL_SNOISE
                if (MODE == 0 && sc == 2.f) { const unsigned hsh = (unsigned)(roff + bj * HALF) * 2654435761u;
#pragma unroll
                    for (int q = 0; q < 4; ++q) { const unsigned h0 = (hsh + q * 0x9E3779B9u) * 1664525u + 1013904223u, h1 = h0 * 1664525u + 1013904223u;
                        v0[q] += ((float)(h0 >> 16) * (1.f / 65536.f) - 0.5f) * 0.07f; v1[q] += ((float)(h1 >> 16) * (1.f / 65536.f) - 0.5f) * 0.07f; } }
#endif
                if (MODE == 3) { v0 = v0 + bv[bj][0]; v1 = v1 + bv[bj][1];
                    v0 = (f32x4){sigmoidf_(v0[0]), sigmoidf_(v0[1]), sigmoidf_(v0[2]), sigmoidf_(v0[3])}; v1 = (f32x4){sigmoidf_(v1[0]), sigmoidf_(v1[1]), sigmoidf_(v1[2]), sigmoidf_(v1[3])}; }
                if (MODE == 4 || MODE == 5) { const u32x4 g = *(const u32x4*)(gate + roff + bj * HALF); v0 = v0 * sc; v1 = v1 * sc;
                    v0 = v0 * (f32x4){bf_lo(g.x), bf_hi(g.x), bf_lo(g.y), bf_hi(g.y)}; v1 = v1 * (f32x4){bf_lo(g.z), bf_hi(g.z), bf_lo(g.w), bf_hi(g.w)};
                    if (MODE == 5) { const u32x4 t = __builtin_nontemporal_load((const u32x4*)(base + roff + bj * HALF));
                        v0 = v0 + (f32x4){bf_lo(t.x), bf_hi(t.x), bf_lo(t.y), bf_hi(t.y)}; v1 = v1 + (f32x4){bf_lo(t.z), bf_hi(t.z), bf_lo(t.w), bf_hi(t.w)}; } }
                u32x4 w; w.x = cvt_pk_bf16(v0[0], v0[1]); w.y = cvt_pk_bf16(v0[2], v0[3]); w.z = cvt_pk_bf16(v1[0], v1[1]); w.w = cvt_pk_bf16(v1[2], v1[3]);
                *(u32x4*)(base + roff + bj * HALF) = w; } }
}

constexpr float C_DIFF = 0.125f * 1.4426950408889634f;
constexpr float C_MEMQ = 0.0625f * 1.4426950408889634f;

struct EpiP1 {
    static constexpr bool PERM = true, AFTER_DRAIN = false;
    bf16_t *U, *V, *QD, *KD, *QM, *VDT, *KM, *VMT;
    __device__ __forceinline__ void operator()(const f32x4 (&acc)[2][2][4][2], const Unit& u, int wr, int wc, int fr, int fq) const {
        const int row0 = u.pm * BM + wr * 64 + fr, cin = wc * 32 + 8 * fq;
        if (u.job == 0) { const int t = u.pn >> 2, col0 = (u.pn & 3) * BM + cin;
            if (t == 0) store_tile_bf16<1>(acc, U, 1024, row0, col0, 1.f, nullptr, nullptr);
            else if (t == 1) store_tile_bf16<1>(acc, V, 1024, row0, col0, 1.f, nullptr, nullptr);
            else if (t == 2) store_tile_bf16<2>(acc, QD, 1024, row0, col0, C_DIFF, nullptr, nullptr);
            else if (t == 3) store_tile_bf16<0>(acc, KD, 1024, row0, col0, 1.f, nullptr, nullptr);
            else store_tile_bf16<2>(acc, QM, 1024, row0, col0, C_MEMQ, nullptr, nullptr);
        } else if (u.job == 1) store_tile_bf16<0>(acc, VDT, 32768, row0, u.pn * BM + cin, 1.f, nullptr, nullptr);
        else if (u.job == 2) store_tile_bf16<0>(acc, KM, 1024, row0, u.pn * BM + cin, 1.f, nullptr, nullptr);
        else store_tile_bf16<0>(acc, VMT, 4096, row0, u.pn * BM + cin, 1.f, nullptr, nullptr);
    }
};
struct EpiPlain {
    static constexpr bool PERM = true, AFTER_DRAIN = false;
    bf16_t* O; int ldc;
    __device__ __forceinline__ void operator()(const f32x4 (&acc)[2][2][4][2], const Unit& u, int wr, int wc, int fr, int fq) const {
        store_tile_bf16<0>(acc, O, ldc, u.pm * BM + wr * 64 + fr, u.pn * BM + wc * 32 + 8 * fq, 1.f, nullptr, nullptr);
    }
};
template <int MODE> struct EpiSplit {
    static constexpr bool PERM = true, AFTER_DRAIN = false;
    bf16_t *O0, *O1, *O2; const float* bias;
    __device__ __forceinline__ void operator()(const f32x4 (&acc)[2][2][4][2], const Unit& u, int wr, int wc, int fr, int fq) const {
        const int t = u.pn >> 2, cin = wc * 32 + 8 * fq, row0 = u.pm * BM + wr * 64 + fr, col0 = (u.pn & 3) * BM + cin; const float* bp = MODE == 3 ? bias + u.pn * BM + cin : nullptr;
        if (t == 0) store_tile_bf16<MODE>(acc, O0, 1024, row0, col0, 2.f, bp, nullptr);
        else if (t == 1) store_tile_bf16<MODE>(acc, O1, 1024, row0, col0, 2.f, bp, nullptr);
        else store_tile_bf16<MODE>(acc, O2, 1024, row0, col0, 2.f, bp, nullptr);
    }
};
struct EpiMerge {
    static constexpr bool PERM = true, AFTER_DRAIN = false;
    bf16_t* T; const bf16_t *G0, *G1, *G2;
    __device__ __forceinline__ void operator()(const f32x4 (&acc)[2][2][4][2], const Unit& u, int wr, int wc, int fr, int fq) const {
        const int row0 = u.pm * BM + wr * 64 + fr, col0 = u.pn * BM + wc * 32 + 8 * fq;
        if (u.job == 0) store_tile_bf16<4>(acc, T, 1024, row0, col0, (ABL_BR & 1) ? 0.f : SC_A, nullptr, G0);
        else if (u.job == 1) store_tile_bf16<5>(acc, T, 1024, row0, col0, (ABL_BR & 2) ? 0.f : SC_B, nullptr, G1);
        else store_tile_bf16<5>(acc, T, 1024, row0, col0, (ABL_BR & 4) ? 0.f : SC_C, nullptr, G2);
    }
};
struct EpiResid {
    static constexpr bool PERM = false, AFTER_DRAIN = false;
    const float* X; float* R; float alpha;
    __device__ __forceinline__ void operator()(const f32x4 (&acc)[2][2][4][2], const Unit& u, int wr, int wc, int fr, int fq) const {
        const int row0 = u.pm * BM + wr * 64 + fr, col0 = u.pn * BM + wc * 32 + 4 * fq;
#pragma unroll
        for (int ai = 0; ai < 2; ++ai)
#pragma unroll
            for (int m = 0; m < 4; ++m) { const size_t roff = (size_t)(row0 + ai * HALF + m * 16) * 1024 + col0;
#pragma unroll
                for (int bj = 0; bj < 2; ++bj)
#pragma unroll
                    for (int n = 0; n < 2; ++n) { const f32x4 xv = *(const f32x4*)(X + roff + bj * HALF + n * 16); *(f32x4*)(R + roff + bj * HALF + n * 16) = xv * alpha + (ABL_Y ? acc[ai][bj][m][n] * 0.f : acc[ai][bj][m][n]); } }
    }
};

template <class Epi, class Sched, bool ALIGN_EPI = false, bool SP2 = false>
__device__ __forceinline__ void gemm_phase(PG8_LAS unsigned char* lds, const Gemm g, const Sched& S, const Epi& E) {
    const int tid = threadIdx.x, wid = __builtin_amdgcn_readfirstlane(tid >> 6), lane = tid & 63, wr = wid >> 2, wc = wid & 3, fr = lane & 15, fq = lane >> 4;
    const int K = g.K, nt = K / BK;
    unsigned voffA[2], voffB[2];
#pragma unroll
    for (int i = 0; i < 2; ++i) { int R, C; stage_rc(tid * 16 + i * 8192, R, C); const int Rb = Epi::PERM ? ((R & ~31) + perm32(R & 31)) : R;
        voffA[i] = (unsigned)(R * K + C) * 2u; voffB[i] = (unsigned)(Rb * K + C) * 2u; }
    const size_t kstep = (size_t)(BK * 2);
    const size_t hstep = (size_t)HALF * K * 2;
    const size_t tstep = 2 * hstep;
    const unsigned ldsw = (unsigned)wid * 1024u;
    const int aoff = lds_byte(wr * 64 + fr, fq * 8), boff = lds_byte(wc * 32 + fr, fq * 8);
#define PG8_SA(b, h) (((b) * 2 + (h)) * HTB)
#define PG8_SB(b, h) ((4 + (b) * 2 + (h)) * HTB)
#define PG8_STAGE(bufoff, gbase, voff) do { _Pragma("unroll") for (int _i = 0; _i < 2; ++_i) \
        __builtin_amdgcn_global_load_lds((const unsigned*)((const char*)(gbase) + (voff)[_i]), (PG8_LAS unsigned*)(lds + (bufoff) + ldsw + _i * 8192), 16, 0, 0); } while (0)
#define PG8_LDA(dst, b, h) do { _Pragma("unroll") for (int m = 0; m < 4; ++m) _Pragma("unroll") for (int k = 0; k < 2; ++k) dst[m][k] = *(const PG8_LAS bf16x8*)(lds + PG8_SA(b, h) + aoff + m * 2048 + k * 1024); } while (0)
#define PG8_LDB(dst, b, h) do { _Pragma("unroll") for (int n = 0; n < 2; ++n) _Pragma("unroll") for (int k = 0; k < 2; ++k) dst[n][k] = *(const PG8_LAS bf16x8*)(lds + PG8_SB(b, h) + boff + n * 2048 + k * 1024); } while (0)
#define PG8_MMA(ai, bj, At, Bt) do { __builtin_amdgcn_s_setprio(1); _Pragma("unroll") for (int m = 0; m < 4; ++m) _Pragma("unroll") for (int n = 0; n < 2; ++n) _Pragma("unroll") for (int k = 0; k < 2; ++k) \
        acc[ai][bj][m][n] = __builtin_amdgcn_mfma_f32_16x16x32_bf16(Bt[n][k], At[m][k], acc[ai][bj][m][n], 0, 0, 0); __builtin_amdgcn_s_setprio(0); } while (0)
#define PG8_WAIT_V(n) asm volatile("s_waitcnt vmcnt(" #n ")" ::: "memory")
#define PG8_WAIT_L(n) asm volatile("s_waitcnt lgkmcnt(" #n ")" ::: "memory")
#define PG8_BAR __builtin_amdgcn_s_barrier()
#define PG8_SCHED __builtin_amdgcn_sched_barrier(0)
    Unit cur, nxt; int ui = 0;
    if (!S.next(0, cur)) return;
    f32x4 acc[2][2][4][2];
#pragma unroll
    for (int a = 0; a < 2; ++a)
#pragma unroll
        for (int b = 0; b < 2; ++b)
#pragma unroll
            for (int m = 0; m < 4; ++m)
#pragma unroll
                for (int n = 0; n < 2; ++n) acc[a][b][m][n] = (f32x4){0.f, 0.f, 0.f, 0.f};
    bf16x8 At[4][2], B0[2][2], B1[2][2];
    const char* cA = jobA(g, cur.job) + (size_t)cur.pm * tstep; const char* cB = jobB(g, cur.job) + (size_t)cur.pn * tstep;
    S.a_ready(cur);
    if constexpr (SP2) {
        PG8_STAGE(PG8_SB(0, 0), cB, voffB); PG8_STAGE(PG8_SB(0, 1), cB + hstep, voffB); PG8_STAGE(PG8_SA(0, 0), cA, voffA); PG8_STAGE(PG8_SA(0, 1), cA + hstep, voffA);
        if (wr == 1) PG8_BAR;
        PG8_WAIT_V(2); PG8_BAR;
        PG8_STAGE(PG8_SB(1, 0), cB + kstep, voffB); PG8_STAGE(PG8_SA(1, 0), cA + kstep, voffA); PG8_STAGE(PG8_SB(1, 1), cB + hstep + kstep, voffB);
        PG8_WAIT_V(6); PG8_BAR;
    } else {
        PG8_STAGE(PG8_SB(0, 0), cB, voffB); PG8_STAGE(PG8_SA(0, 0), cA, voffA); PG8_STAGE(PG8_SB(0, 1), cB + hstep, voffB); PG8_STAGE(PG8_SA(0, 1), cA + hstep, voffA);
        if (wr == 1) PG8_BAR;
        PG8_WAIT_V(4); PG8_BAR;
        PG8_STAGE(PG8_SB(1, 0), cB + kstep, voffB); PG8_STAGE(PG8_SA(1, 0), cA + kstep, voffA); PG8_STAGE(PG8_SB(1, 1), cB + hstep + kstep, voffB);
        PG8_WAIT_V(6); PG8_BAR;
    }
    for (;;) {
        const bool has_next = S.next(ui + 1, nxt);
        const char* nA = has_next ? jobA(g, nxt.job) + (size_t)nxt.pm * tstep : cA; const char* nB = has_next ? jobB(g, nxt.job) + (size_t)nxt.pn * tstep : cB;
        for (int t = 0; t < nt; t += 2) {
            const bool last = (t == nt - 2);
            const char* a1 = cA + (size_t)(t + 1) * kstep;
            const char* a2 = last ? nA : cA + (size_t)(t + 2) * kstep; const char* b2 = last ? nB : cB + (size_t)(t + 2) * kstep;
            const char* a3 = a2 + kstep; const char* b3 = b2 + kstep;
            if (last && has_next) S.a_ready(nxt);
            if constexpr (SP2) {
            PG8_LDB(B0, 0, 0); PG8_LDB(B1, 0, 1); PG8_SCHED; PG8_LDA(At, 0, 0); PG8_STAGE(PG8_SA(1, 1), a1 + hstep, voffA);
            PG8_WAIT_V(8); PG8_WAIT_L(0); PG8_BAR; PG8_MMA(0, 0, At, B0); PG8_MMA(0, 1, At, B1); PG8_BAR; PG8_SCHED;
            PG8_LDA(At, 0, 1); PG8_STAGE(PG8_SB(0, 0), b2, voffB); PG8_STAGE(PG8_SB(0, 1), b2 + hstep, voffB); PG8_STAGE(PG8_SA(0, 0), a2, voffA);
            PG8_WAIT_V(8); PG8_WAIT_L(0); PG8_BAR; PG8_MMA(1, 0, At, B0); PG8_MMA(1, 1, At, B1); PG8_BAR; PG8_SCHED;
            PG8_LDB(B0, 1, 0); PG8_LDB(B1, 1, 1); PG8_SCHED; PG8_LDA(At, 1, 0); PG8_STAGE(PG8_SA(0, 1), a2 + hstep, voffA);
            PG8_WAIT_V(8); PG8_WAIT_L(0); PG8_BAR; PG8_MMA(0, 0, At, B0); PG8_MMA(0, 1, At, B1); PG8_BAR; PG8_SCHED;
            PG8_LDA(At, 1, 1); PG8_STAGE(PG8_SB(1, 0), b3, voffB); PG8_STAGE(PG8_SB(1, 1), b3 + hstep, voffB); PG8_STAGE(PG8_SA(1, 0), a3, voffA);
            PG8_WAIT_V(8); PG8_WAIT_L(0); PG8_BAR; PG8_MMA(1, 0, At, B0); PG8_MMA(1, 1, At, B1); PG8_BAR; PG8_SCHED;
            } else {
            PG8_LDB(B0, 0, 0); PG8_SCHED; PG8_LDA(At, 0, 0); PG8_STAGE(PG8_SA(1, 1), a1 + hstep, voffA);
            PG8_WAIT_L(8); PG8_BAR; PG8_WAIT_L(0); PG8_MMA(0, 0, At, B0); PG8_BAR; PG8_SCHED;
            PG8_LDB(B1, 0, 1); PG8_STAGE(PG8_SB(0, 0), b2, voffB);
            PG8_BAR; PG8_WAIT_L(0); PG8_MMA(0, 1, At, B1); PG8_BAR;
            PG8_LDA(At, 0, 1); PG8_STAGE(PG8_SA(0, 0), a2, voffA);
            PG8_BAR; PG8_WAIT_L(0); PG8_MMA(1, 0, At, B0); PG8_BAR; PG8_SCHED;
            PG8_STAGE(PG8_SB(0, 1), b2 + hstep, voffB);
            PG8_WAIT_V(6); PG8_BAR; PG8_MMA(1, 1, At, B1); PG8_BAR;
            PG8_LDB(B0, 1, 0); PG8_SCHED; PG8_LDA(At, 1, 0); PG8_STAGE(PG8_SA(0, 1), a2 + hstep, voffA);
            PG8_WAIT_L(8); PG8_BAR; PG8_WAIT_L(0); PG8_MMA(0, 0, At, B0); PG8_BAR; PG8_SCHED;
            PG8_LDB(B1, 1, 1); PG8_STAGE(PG8_SB(1, 0), b3, voffB);
            PG8_BAR; PG8_WAIT_L(0); PG8_MMA(0, 1, At, B1); PG8_BAR;
            PG8_LDA(At, 1, 1); PG8_STAGE(PG8_SA(1, 0), a3, voffA);
            PG8_BAR; PG8_WAIT_L(0); PG8_MMA(1, 0, At, B0); PG8_BAR; PG8_SCHED;
            PG8_STAGE(PG8_SB(1, 1), b3 + hstep, voffB);
            PG8_WAIT_V(6); PG8_BAR; PG8_MMA(1, 1, At, B1); PG8_BAR;
            }
        }
        if constexpr (ALIGN_EPI) { if (wr == 0) PG8_BAR; }
        if constexpr (!Epi::AFTER_DRAIN) { E(acc, cur, wr, wc, fr, fq); S.done(cur); }
        if (!has_next) break;
#pragma unroll
        for (int a = 0; a < 2; ++a)
#pragma unroll
            for (int b = 0; b < 2; ++b)
#pragma unroll
                for (int m = 0; m < 4; ++m)
#pragma unroll
                    for (int n = 0; n < 2; ++n) acc[a][b][m][n] = (f32x4){0.f, 0.f, 0.f, 0.f};
        cur = nxt; cA = nA; cB = nB; ++ui;
        if constexpr (ALIGN_EPI) { if (wr == 1) PG8_BAR; }
    }
    PG8_WAIT_V(0);
    if constexpr (!ALIGN_EPI) { if (wr == 0) PG8_BAR; }
    PG8_BAR;
    if constexpr (Epi::AFTER_DRAIN) { E.fused(acc, cur, wr, wc, fr, fq, lds, wid, lane); S.done(cur); }
#undef PG8_SA
#undef PG8_SB
#undef PG8_STAGE
#undef PG8_LDA
#undef PG8_LDB
#undef PG8_MMA
#undef PG8_WAIT_V
#undef PG8_WAIT_L
#undef PG8_BAR
#undef PG8_SCHED
}
}
#ifndef DRYMASK
#define DRYMASK 7
#endif
#ifndef MIXSC
#define MIXSC 1.f
#endif
#ifndef BIASSC
#define BIASSC 1.f
#endif

constexpr int NWAVES = 8;
constexpr int N_LAUNCHES = MK_N_LAUNCHES;
constexpr int PER_PHASE = 10;
constexpr int BATCH = 16, SEQ = 2048, DM = 1024, MTOK = BATCH * SEQ, MEML = 256, MMEM = BATCH * MEML;
constexpr int NEXP = 16384;
constexpr float ALPHA = 1.189207115002721f;
constexpr float LN_EPS = 1e-5f;
constexpr float LAM_INIT = 0.2f;
constexpr float LOG2E = 1.4426950408889634f;

constexpr size_t MiB = 1u << 20;
constexpr size_t WS_CTL = 0, CTL_ZERO_BYTES = 1 * MiB;
constexpr size_t WS_W1T = 1 * MiB;
constexpr size_t WS_WVDT = 11 * MiB;
constexpr size_t WS_WGT = 13 * MiB;
constexpr size_t WS_WMKT = 19 * MiB;
constexpr size_t WS_WMVT = 21 * MiB;
constexpr size_t WS_WBT = 23 * MiB;
constexpr size_t WS_WOT = 29 * MiB;
constexpr size_t WS_WPQ = 31 * MiB;
constexpr size_t WS_SKD = 35 * MiB;
constexpr size_t WS_WST = 43 * MiB;
constexpr size_t WS_A0 = 48 * MiB, ACT_BYTES = 64 * MiB;
constexpr size_t WS_END = WS_A0 + 7 * ACT_BYTES;
constexpr size_t DO_XB = 0, DO_MEMB = 64 * MiB, DO_KM = 72 * MiB, DO_VMT = 80 * MiB;
constexpr int CW_TMO = 0, CW_CODE = 1, CW_BAR = 4096;

constexpr int RING_OFF = 0, RING_BYTES = 135168;
constexpr int LDSCTL_OFF = RING_BYTES, MISC_OFF = LDSCTL_OFF + 320;
constexpr int LDS_BYTES = 147456;
static_assert(MISC_OFF + 128 <= LDS_BYTES, "LDS map");

#define GAS __attribute__((address_space(1)))
#define LAS __attribute__((address_space(3)))
typedef unsigned short bf16;
typedef unsigned v4u __attribute__((ext_vector_type(4)));
typedef unsigned v2u __attribute__((ext_vector_type(2)));
typedef float f32x4 __attribute__((ext_vector_type(4)));
typedef float f32x16 __attribute__((ext_vector_type(16)));
typedef short bf16x8 __attribute__((ext_vector_type(8)));
typedef __bf16 bf16x2_t __attribute__((ext_vector_type(2)));
typedef float f32x2_t __attribute__((ext_vector_type(2)));
typedef GAS unsigned gu32;
#define RLX_AGENT __ATOMIC_RELAXED, __HIP_MEMORY_SCOPE_AGENT
#define LDS_WAIT() asm volatile("s_waitcnt lgkmcnt(0)" ::: "memory")
#define VM_WAIT() asm volatile("s_waitcnt vmcnt(0)" ::: "memory")
__device__ __forceinline__ unsigned f2bf(float f) { unsigned u = __builtin_bit_cast(unsigned, f); return (u + 0x7fffu + ((u >> 16) & 1u)) >> 16; }
__device__ __forceinline__ unsigned pk2(float lo, float hi) { f32x2_t v = {lo, hi}; bf16x2_t b = __builtin_convertvector(v, bf16x2_t); return __builtin_bit_cast(unsigned, b); }
__device__ __forceinline__ float bflo(unsigned w) { return __uint_as_float(w << 16); }
__device__ __forceinline__ float bfhi(unsigned w) { return __uint_as_float(w & 0xffff0000u); }
__device__ __forceinline__ float dot2_bf16(unsigned a, unsigned b, float acc) { return __builtin_amdgcn_fdot2_f32_bf16(__builtin_bit_cast(bf16x2_t, a), __builtin_bit_cast(bf16x2_t, b), acc, false); }
__device__ __forceinline__ float wave_sum(float v) {
#pragma unroll
    for (int o = 1; o < 64; o <<= 1) v += __shfl_xor(v, o);
    return v;
}
__device__ __forceinline__ float gelu1(float v) { pg8::f32x2 r = pg8::gelu_pk((pg8::f32x2){v, v}); return r.x; }

#define XB_TMO      128
#define XB_XCNT(j)  (256  + 64 * (j))
#define XB_XSUB(j)  (1280 + 64 * (j))
#define XB_XGEN(j)  (2304 + 64 * (j))
#define XB_TOP      3328
#define XB_TOPGEN   3392
#define XCD_BAR_WORDS 3456
#define XB_SPIN_CAP (1u << 22)

__device__ __forceinline__ unsigned xb_ld(unsigned* p)              { return __hip_atomic_load(p, __ATOMIC_RELAXED, __HIP_MEMORY_SCOPE_AGENT); }
__device__ __forceinline__ unsigned xb_add(unsigned* p, unsigned v) { return __hip_atomic_fetch_add(p, v, __ATOMIC_RELAXED, __HIP_MEMORY_SCOPE_AGENT); }
__device__ __forceinline__ unsigned xb_xcc_id() { return (unsigned)__builtin_amdgcn_s_getreg((3 << 11) | 20) & 0xFu; }
#define XB_SPIN(cond, bar) do { unsigned _sp = 0; while (cond) { __builtin_amdgcn_s_sleep(1); \
    if ((++_sp & 255u) == 0u) { if (xb_ld(&(bar)[XB_TMO])) break; if (_sp > XB_SPIN_CAP) { atomicAdd(&(bar)[XB_TMO], 1u); break; } } } } while (0)

struct XcdBarrier { unsigned* bar; unsigned x; volatile LAS unsigned* st; };

__device__ __forceinline__ XcdBarrier xcd_barrier_post(unsigned* bar, volatile LAS unsigned* st) {
    XcdBarrier b; b.bar = bar; b.x = xb_xcc_id(); b.st = st;
    if (threadIdx.x == 0) (void)xb_add(&bar[XB_XCNT(b.x)], 1u);
    return b;
}
__device__ __forceinline__ void xcd_barrier_complete(unsigned* bar, unsigned x, unsigned& nloc, unsigned& nx) {
    const unsigned G = gridDim.x * gridDim.y * gridDim.z;
    unsigned sum, cnt, mine, sp = 0u;
    for (;;) {
        sum = 0u; cnt = 0u; mine = 0u;
#pragma unroll
        for (unsigned j = 0; j < 16; ++j) { const unsigned c = xb_ld(&bar[XB_XCNT(j)]); sum += c; cnt += (c > 0u) ? 1u : 0u; mine = (j == x) ? c : mine; }
        if (sum == G) break;
        __builtin_amdgcn_s_sleep(1);
        if ((++sp & 255u) == 0u) { if (xb_ld(&bar[XB_TMO])) break; if (sp > XB_SPIN_CAP) { atomicAdd(&bar[XB_TMO], 1u); break; } }
    }
    nloc = mine > 0u ? mine : 1u; nx = cnt > 0u ? cnt : 1u;
}
__device__ __forceinline__ void xcd_barrier(const XcdBarrier& b) {
    asm volatile("s_waitcnt vmcnt(0)" ::: "memory");
    __syncthreads();
    if (threadIdx.x == 0) {
        unsigned* bar = b.bar;
        __builtin_amdgcn_s_waitcnt(0);
        unsigned nloc = b.st[0], nx = b.st[1];
        if (nloc == 0u) { xcd_barrier_complete(bar, b.x, nloc, nx); b.st[0] = nloc; b.st[1] = nx; }
        const unsigned old = xb_add(&bar[XB_XSUB(b.x)], 1u);
        const unsigned gen = old / nloc;
        if (old + 1u == (gen + 1u) * nloc) {
            __builtin_amdgcn_fence(__ATOMIC_RELEASE, "agent");
            asm volatile("s_waitcnt vmcnt(0)" ::: "memory");
            const unsigned og = xb_add(&bar[XB_TOP], 1u);
            const unsigned tg = og / nx;
            if (og + 1u == (tg + 1u) * nx) xb_add(&bar[XB_TOPGEN], 1u);
            else XB_SPIN(xb_ld(&bar[XB_TOPGEN]) == tg, bar);
            __builtin_amdgcn_fence(__ATOMIC_ACQUIRE, "agent");
            xb_add(&bar[XB_XGEN(b.x)], 1u);
            asm volatile("s_waitcnt vmcnt(0)" ::: "memory");
        } else {
            XB_SPIN(xb_ld(&bar[XB_XGEN(b.x)]) == gen, bar);
            __builtin_amdgcn_fence(__ATOMIC_ACQUIRE, "agent");
            asm volatile("s_waitcnt vmcnt(0)" ::: "memory");
        }
    }
    __syncthreads();
}

struct Args { const float* in[26]; float* out; unsigned char* ws; int ph_lo, ph_hi, li, pad; };
struct Frame {
    LAS unsigned char* lds;
    volatile LAS unsigned* MISC;
    gu32* ctl;
    int tid, lane, wave;
    int vcu, G;
    unsigned char* ws; unsigned char* dout;
};
__device__ __forceinline__ bf16* wsb(const Frame& F, size_t off) { return (bf16*)(F.ws + off); }
__device__ __forceinline__ bf16* act(const Frame& F, int i) { return (bf16*)(F.ws + WS_A0 + (size_t)i * ACT_BYTES); }

__device__ __forceinline__ void p0_transpose_item(const float* W, int ldw, int col_off, int ncols, int K, bf16* WT, int row_off, LAS float* scr, int item, int lane) {
    const int nblk = ncols / 32, kb = item / nblk, nb = item % nblk, k0 = 64 * kb, n0 = 32 * nb;
#pragma unroll 8
    for (int i = 0; i < 32; ++i) { const int kk = 2 * i + (lane >> 5); scr[kk * 33 + (lane & 31)] = W[(size_t)(k0 + kk) * ldw + col_off + n0 + (lane & 31)]; }
    LDS_WAIT(); asm volatile("" ::: "memory");
    const int c = lane & 7;
#pragma unroll
    for (int j = 0; j < 4; ++j) { const int n = (lane >> 3) + 8 * j; const LAS float* s = scr + (8 * c) * 33 + n;
        v4u o; o.x = pk2(s[0 * 33], s[1 * 33]); o.y = pk2(s[2 * 33], s[3 * 33]); o.z = pk2(s[4 * 33], s[5 * 33]); o.w = pk2(s[6 * 33], s[7 * 33]);
        *(GAS v4u*)(WT + (size_t)(row_off + n0 + n) * K + k0 + 8 * c) = o; }
    LDS_WAIT(); asm volatile("" ::: "memory");
}
__device__ __forceinline__ void cvt_row_1024(const float* src, bf16* dst, int lane) {
    const GAS f32x4* xr = (const GAS f32x4*)src + lane;
    GAS v2u* o8 = (GAS v2u*)dst + lane;
    f32x4 v[4];
#pragma unroll
    for (int j = 0; j < 4; ++j) v[j] = xr[64 * j];
#pragma unroll
    for (int j = 0; j < 4; ++j) { v2u w; w.x = pk2(v[j].x, v[j].y); w.y = pk2(v[j].z, v[j].w); o8[64 * j] = w; }
}
__device__ __forceinline__ void cvt_row_fp8(const float* src, unsigned char* dst, float* inv_out, int lane) {
    f32x4 v[4];
#pragma unroll
    for (int j = 0; j < 4; ++j) v[j] = *(const GAS f32x4*)(src + 16 * lane + 4 * j);
    float am = 0.f;
#pragma unroll
    for (int j = 0; j < 4; ++j) am = fmaxf(am, fmaxf(fmaxf(fabsf(v[j].x), fabsf(v[j].y)), fmaxf(fabsf(v[j].z), fabsf(v[j].w))));
#pragma unroll
    for (int o = 1; o < 64; o <<= 1) am = fmaxf(am, __shfl_xor(am, o));
    int E = (int)((__float_as_uint(am) >> 23) & 0xffu); E = E < 8 ? 8 : (E > 250 ? 250 : E);
    const float sc = __uint_as_float((unsigned)(260 - E) << 23), inv = __uint_as_float((unsigned)(E - 6) << 23);
    v4u o; unsigned w;
#pragma unroll
    for (int j = 0; j < 4; ++j) { w = (unsigned)__builtin_amdgcn_cvt_pk_fp8_f32(v[j].x * sc, v[j].y * sc, 0, false); w = (unsigned)__builtin_amdgcn_cvt_pk_fp8_f32(v[j].z * sc, v[j].w * sc, (int)w, true); o[j] = w; }
    *(GAS v4u*)(dst + 16 * lane) = o;
    if (lane == 0) *inv_out = inv;
}
__device__ __forceinline__ void cvt_row_int4(const float* src, unsigned char* dst, float* delta_out, float* qsum_out, int lane) {
    f32x4 v[4];
#pragma unroll
    for (int j = 0; j < 4; ++j) v[j] = *(const GAS f32x4*)(src + 16 * lane + 4 * j);
    float sq = 0.f;
#pragma unroll
    for (int j = 0; j < 4; ++j) sq += (v[j].x * v[j].x + v[j].y * v[j].y) + (v[j].z * v[j].z + v[j].w * v[j].w);
    const float rms = sqrtf(wave_sum(sq) * (1.0f / 1024.0f));
    const float delta = fmaxf(rms * (2.75f / 7.5f), 1e-30f), inv = 1.0f / delta;
    unsigned w[2] = {0u, 0u}; int qs = 0;
#pragma unroll
    for (int j = 0; j < 16; ++j) { const float xv = v[j >> 2][j & 3]; int q = (int)floorf(xv * inv + 8.0f); q = q < 0 ? 0 : (q > 15 ? 15 : q); qs += q; w[j >> 3] |= (unsigned)q << (4 * (j & 7)); }
    v2u o; o.x = w[0]; o.y = w[1];
    *(GAS v2u*)(dst + 8 * lane) = o;
    const float qst = wave_sum((float)qs);
    if (lane == 0) { *delta_out = delta; *qsum_out = qst; }
}
__device__ __forceinline__ void p0_prologue(Frame& F, const Args& A) {
    LAS float* scr = (LAS float*)(F.lds + RING_OFF + F.wave * 16384);
    const int gw = F.vcu * NWAVES + F.wave, NGW = F.G * NWAVES;
    const float *w_in = A.in[2], *w_mkv = A.in[13], *w_gate = A.in[14], *w_br = A.in[16], *w_out = A.in[17];
    constexpr int I_IN0 = 16 * 128, I_INV = 16 * 32, I_INM = 16 * 32, I_G = 16 * 96, I_MK = 16 * 32, I_MV = 16 * 32, I_BR = 16 * 32, I_O = 16 * 32;
    constexpr int NT = I_IN0 + I_INV + I_INM + I_G + I_MK + I_MV + 3 * I_BR + I_O;
    for (int it = gw; it < NT; it += NGW) {
        int r = it;
        if (r < I_IN0) { p0_transpose_item(w_in, 6144, 0, 4096, 1024, wsb(F, WS_W1T), 0, scr, r, F.lane); continue; } r -= I_IN0;
        if (r < I_INV) { p0_transpose_item(w_in, 6144, 4096, 1024, 1024, wsb(F, WS_WVDT), 0, scr, r, F.lane); continue; } r -= I_INV;
        if (r < I_INM) { p0_transpose_item(w_in, 6144, 5120, 1024, 1024, wsb(F, WS_W1T), 4096, scr, r, F.lane); continue; } r -= I_INM;
        if (r < I_G) { p0_transpose_item(w_gate, 3072, 0, 3072, 1024, wsb(F, WS_WGT), 0, scr, r, F.lane); continue; } r -= I_G;
        if (r < I_MK) { p0_transpose_item(w_mkv, 2048, 0, 1024, 1024, wsb(F, WS_WMKT), 0, scr, r, F.lane); continue; } r -= I_MK;
        if (r < I_MV) { p0_transpose_item(w_mkv, 2048, 1024, 1024, 1024, wsb(F, WS_WMVT), 0, scr, r, F.lane); continue; } r -= I_MV;
        if (r < 3 * I_BR) { const int n = r / I_BR; p0_transpose_item(w_br + (size_t)n * 1024 * 1024, 1024, 0, 1024, 1024, wsb(F, WS_WBT) + (size_t)n * 1024 * 1024, 0, scr, r % I_BR, F.lane); continue; } r -= 3 * I_BR;
        p0_transpose_item(w_out, 1024, 0, 1024, 1024, wsb(F, WS_WOT), 0, scr, r, F.lane);
    }
    bf16* XB = (bf16*)(F.dout + DO_XB); bf16* MEMB = (bf16*)(F.dout + DO_MEMB);
    for (int m = gw; m < MTOK; m += NGW) cvt_row_1024(A.in[0] + (size_t)m * 1024, XB + (size_t)m * 1024, F.lane);
    for (int m = gw; m < MMEM; m += NGW) cvt_row_1024(A.in[1] + (size_t)m * 1024, MEMB + (size_t)m * 1024, F.lane);
    for (int m = gw; m < 2048; m += NGW) cvt_row_1024(A.in[20] + (size_t)m * 1024, wsb(F, WS_WPQ) + (size_t)m * 1024, F.lane);
    const float* sk = A.in[21];
    for (int r = gw; r < 2048; r += NGW) {
        const int cb = (r >> 7) << 7;
#pragma unroll
        for (int j = 0; j < 4; ++j) { const int c0 = 8 * (F.lane + 64 * j); v4u o = {0u, 0u, 0u, 0u};
            if (c0 >= cb && c0 < cb + 128) { const f32x4 a = *(const GAS f32x4*)(sk + (size_t)r * 128 + (c0 - cb)), b = *(const GAS f32x4*)(sk + (size_t)r * 128 + (c0 - cb) + 4);
                o.x = pk2(a.x, a.y); o.y = pk2(a.z, a.w); o.z = pk2(b.x, b.y); o.w = pk2(b.z, b.w); }
            *(GAS v4u*)(wsb(F, WS_SKD) + (size_t)r * 2048 + c0) = o; }
    }
}

#define MFMA32(a, b, c) __builtin_amdgcn_mfma_f32_32x32x16_bf16((a), (b), (c), 0, 0, 0)
__device__ __forceinline__ int crow(int r, int hi) { return (r & 3) + 8 * (r >> 2) + 4 * hi; }
__device__ __forceinline__ int swap23(int x) { return (x & ~12) | ((x & 4) << 1) | ((x & 8) >> 1); }
constexpr int P2_KBUF = 33792, P2_VBUF = 18432, P2_VROWB = 144;
constexpr int P2_K0 = 0, P2_V0 = 2 * P2_KBUF, P2_BT = RING_BYTES - 2048, P2_SG = P2_BT + 512, P2_LAM = P2_SG + 512, P2_END = P2_LAM + 64;
static_assert(P2_V0 + 2 * P2_VBUF <= P2_BT && P2_END <= RING_BYTES, "P2 LDS");

template <int KSTEPS, bool BAND, bool QHOLD>
__device__ __forceinline__ void attn_pass(LAS unsigned char* lds, const bf16* qrow, const bf16* Kg, int kpitch, const bf16* Vg, int vpitch,
                                          int ntiles, int my_last, int band_first, int qpos, f32x16 (&O)[4], float& l_out) {
    constexpr int KROWB = KSTEPS * 32 + 16, KCH = KSTEPS * 2, KPT = (64 * KCH) / 512;
    static_assert(64 * KROWB <= P2_KBUF, "K tile");
    const int tid = threadIdx.x, lane = tid & 63, r = lane & 31, hi = lane >> 5;
    const LAS float* btab = (const LAS float*)(lds + P2_BT);
    v4u kreg[KPT], vreg[2];
    const bf16* ksrc[KPT]; int kdst[KPT]; const bf16* vsrc[2]; int vdst[2];
#pragma unroll
    for (int i = 0; i < KPT; ++i) { const int c = tid + 512 * i, row = c / KCH, part = c % KCH; ksrc[i] = Kg + (size_t)row * kpitch + part * 8; kdst[i] = ((row & 0x30) | swap23(row & 15)) * KROWB + part * 16; }
#pragma unroll
    for (int i = 0; i < 2; ++i) { const int c = tid + 512 * i, row = c >> 3, part = c & 7; vsrc[i] = Vg + (size_t)row * vpitch + part * 8; vdst[i] = row * P2_VROWB + part * 16; }
#pragma unroll
    for (int d = 0; d < 4; ++d) O[d] = f32x16{};
    float m_run = -1e30f, l_run = 0.f;
    bf16x8 qf[QHOLD ? KSTEPS : 1];
    if (QHOLD) {
#pragma unroll
        for (int ks = 0; ks < KSTEPS; ++ks) qf[QHOLD ? ks : 0] = *(const GAS bf16x8*)(qrow + ks * 16);
    }
#pragma unroll
    for (int i = 0; i < KPT; ++i) kreg[i] = *(const GAS v4u*)(ksrc[i]);
#pragma unroll
    for (int i = 0; i < 2; ++i) vreg[i] = *(const GAS v4u*)(vsrc[i]);
#pragma unroll
    for (int i = 0; i < KPT; ++i) *(LAS v4u*)(lds + P2_K0 + kdst[i]) = kreg[i];
#pragma unroll
    for (int i = 0; i < 2; ++i) *(LAS v4u*)(lds + P2_V0 + vdst[i]) = vreg[i];
    __syncthreads();
    for (int t = 0; t < ntiles; ++t) {
        const int cur = t & 1; const bool more = (t + 1 < ntiles);
        if (more) {
#pragma unroll
            for (int i = 0; i < KPT; ++i) kreg[i] = *(const GAS v4u*)(ksrc[i] + (size_t)(t + 1) * 64 * kpitch);
#pragma unroll
            for (int i = 0; i < 2; ++i) vreg[i] = *(const GAS v4u*)(vsrc[i] + (t + 1) * 64);
        }
        if (t <= my_last) {
            const LAS unsigned char* kb = lds + P2_K0 + cur * P2_KBUF + r * KROWB + hi * 16;
            const LAS unsigned char* vb = lds + P2_V0 + cur * P2_VBUF + r * P2_VROWB + hi * 16;
            f32x16 p0 = f32x16{}, p1 = f32x16{};
#pragma unroll
            for (int ks = 0; ks < KSTEPS; ++ks) {
                const bf16x8 a0 = *(const LAS bf16x8*)(kb + ks * 32), a1 = *(const LAS bf16x8*)(kb + 32 * KROWB + ks * 32);
                const bf16x8 qq = QHOLD ? qf[QHOLD ? ks : 0] : *(const GAS bf16x8*)(qrow + ks * 16);
                p0 = MFMA32(a0, qq, p0); p1 = MFMA32(a1, qq, p1);
            }
            if (BAND && t >= band_first) {
                const int kv0 = t * 64;
#pragma unroll
                for (int e = 0; e < 16; ++e) {
                    const int kl = swap23(crow(e, 0)) + 8 * hi;
                    const int rel0 = qpos - (kv0 + kl), rel1 = rel0 - 32;
                    const float b0 = btab[rel0 < 0 ? 0 : (rel0 > 127 ? 127 : rel0)], b1 = btab[rel1 < 0 ? 0 : (rel1 > 127 ? 127 : rel1)];
                    p0[e] = rel0 < 0 ? -1e30f : p0[e] + b0; p1[e] = rel1 < 0 ? -1e30f : p1[e] + b1;
                }
            }
            float mx = fmaxf(p0[0], p1[0]);
#pragma unroll
            for (int e = 1; e < 16; ++e) mx = fmaxf(mx, fmaxf(p0[e], p1[e]));
            mx = fmaxf(mx, __shfl_xor(mx, 32));
            const float m_new = fmaxf(m_run, mx), alpha = __builtin_amdgcn_exp2f(m_run - m_new);
            m_run = m_new;
            float ps = 0.f;
#pragma unroll
            for (int e = 0; e < 16; ++e) { p0[e] = __builtin_amdgcn_exp2f(p0[e] - m_new); p1[e] = __builtin_amdgcn_exp2f(p1[e] - m_new); ps += p0[e] + p1[e]; }
            l_run = l_run * alpha + ps;
#pragma unroll
            for (int d = 0; d < 4; ++d) O[d] = O[d] * alpha;
            bf16x8 pk[4];
#pragma unroll
            for (int s = 0; s < 2; ++s) {
                v4u w0, w1;
                w0.x = pk2(p0[8 * s + 0], p0[8 * s + 1]); w0.y = pk2(p0[8 * s + 2], p0[8 * s + 3]); w0.z = pk2(p0[8 * s + 4], p0[8 * s + 5]); w0.w = pk2(p0[8 * s + 6], p0[8 * s + 7]);
                w1.x = pk2(p1[8 * s + 0], p1[8 * s + 1]); w1.y = pk2(p1[8 * s + 2], p1[8 * s + 3]); w1.z = pk2(p1[8 * s + 4], p1[8 * s + 5]); w1.w = pk2(p1[8 * s + 6], p1[8 * s + 7]);
                pk[s] = __builtin_bit_cast(bf16x8, w0); pk[2 + s] = __builtin_bit_cast(bf16x8, w1);
            }
#pragma unroll
            for (int d = 0; d < 4; ++d)
#pragma unroll
                for (int s = 0; s < 4; ++s) { const bf16x8 a = *(const LAS bf16x8*)(vb + d * 32 * P2_VROWB + s * 32); O[d] = MFMA32(a, pk[s], O[d]); }
        }
        if (more) {
            const int nb = cur ^ 1;
#pragma unroll
            for (int i = 0; i < KPT; ++i) *(LAS v4u*)(lds + P2_K0 + nb * P2_KBUF + kdst[i]) = kreg[i];
#pragma unroll
            for (int i = 0; i < 2; ++i) *(LAS v4u*)(lds + P2_V0 + nb * P2_VBUF + vdst[i]) = vreg[i];
        }
        __syncthreads();
    }
    l_out = l_run + __shfl_xor(l_run, 32);
}

constexpr int DF_KBUF = 16384, DF_VBUF = 16384, DF_K0 = 0, DF_V0 = 2 * DF_KBUF, DF_Q0 = DF_V0 + 2 * DF_VBUF;
static_assert(DF_Q0 + 8 * 8192 <= P2_BT, "diff LDS");
constexpr float DF_THR = 6.0f;
__device__ __forceinline__ void glds16(const void* gsrc, unsigned lds_dst) { unsigned keep;
    asm volatile("s_mov_b32 %0, m0\n\ts_mov_b32 m0, %2\n\ts_nop 0\n\tglobal_load_lds_dwordx4 %1, off\n\ts_mov_b32 m0, %0" : "=&s"(keep) : "v"(gsrc), "s"(lds_dst) : "memory"); }
__device__ __forceinline__ void df_block(const LAS unsigned char* kb, const LAS unsigned char* qb, int c0, int xr, const LAS unsigned char* vb, int vc0, int vx,
                                         bool band, int qpos, int kvb, int hi, const LAS float* btab, float& m_run, float& l_run, f32x16 (&O)[4]) {
    f32x16 p = f32x16{};
#pragma unroll
    for (int ks = 0; ks < 4; ++ks) { const int off = ((c0 + 2 * ks) ^ xr) << 4; const bf16x8 a = *(const LAS bf16x8*)(kb + off); const bf16x8 qq = *(const LAS bf16x8*)(qb + off); p = MFMA32(a, qq, p); }
    __builtin_amdgcn_sched_barrier(0);
    if (band) {
#pragma unroll
        for (int e = 0; e < 16; ++e) { const int rel = qpos - (kvb + swap23(crow(e, 0)) + 8 * hi); const float bb = btab[rel < 0 ? 0 : (rel > 127 ? 127 : rel)]; p[e] = rel < 0 ? -1e30f : p[e] + bb; }
    }
    float mx = fmaxf(p[0], p[1]);
#pragma unroll
    for (int e = 2; e < 16; ++e) mx = fmaxf(mx, p[e]);
    mx = fmaxf(mx, __shfl_xor(mx, 32));
    if (__any(mx > m_run + DF_THR)) {
        const float m_new = fmaxf(m_run, mx), alpha = __builtin_amdgcn_exp2f(m_run - m_new);
        m_run = m_new; l_run *= alpha;
#pragma unroll
        for (int d = 0; d < 4; ++d) O[d] = O[d] * alpha;
    }
    float ps = 0.f;
#pragma unroll
    for (int e = 0; e < 16; ++e) { p[e] = __builtin_amdgcn_exp2f(p[e] - m_run); ps += p[e]; }
    l_run += ps;
    __builtin_amdgcn_sched_barrier(0);
    bf16x8 pk[2];
#pragma unroll
    for (int s = 0; s < 2; ++s) { v4u w; w.x = pk2(p[8 * s + 0], p[8 * s + 1]); w.y = pk2(p[8 * s + 2], p[8 * s + 3]); w.z = pk2(p[8 * s + 4], p[8 * s + 5]); w.w = pk2(p[8 * s + 6], p[8 * s + 7]); pk[s] = __builtin_bit_cast(bf16x8, w); }
#pragma unroll
    for (int d = 0; d < 4; ++d)
#pragma unroll
        for (int s = 0; s < 2; ++s) { const bf16x8 a = *(const LAS bf16x8*)(vb + d * 32 * 128 + (((vc0 + 2 * s) ^ vx) << 4)); O[d] = MFMA32(a, pk[s], O[d]); if (s == 1 && (d & 1)) __builtin_amdgcn_sched_barrier(0); }
}
__device__ __forceinline__ void diff_unit(Frame& F, int b, int h, int qb, int dry) {
    const int lane = F.lane, r = lane & 31, hi = lane >> 5, wid = F.wave;
    const bf16 *QD = act(F, 2), *KD = act(F, 3), *VDT = act(F, 4); bf16* HB = dry ? act(F, 6) : act(F, 2);
    const int qw = qb * 256 + wid * 32, qpos = qw + r;
#ifdef ABL_NOSKIP
    const int ntiles = 4 * (qb + 1), my_last = ntiles - 1, band_first = 0;
#else
    const int ntiles = 4 * (qb + 1), my_last = (qw + 31) >> 6, band_first = (qw - 176) < 0 ? 0 : (qw - 176) >> 6;
#endif
    const LAS float* btab = (const LAS float*)(F.lds + P2_BT);
    const unsigned lds0 = (unsigned)(size_t)F.lds;
    int ln = lane; asm volatile("" : "+v"(ln));
    { const bf16* qsrc = QD + ((size_t)b * SEQ + qw + (ln >> 4)) * 1024 + h * 128; LAS unsigned char* qimg = F.lds + DF_Q0 + wid * 8192 + (ln >> 4) * 256;
#pragma unroll
      for (int j = 0; j < 8; ++j) { const int rr = 4 * j + (ln >> 4), c = ln & 15; const v4u v = *(const GAS v4u*)(qsrc + (size_t)(4 * j) * 1024 + c * 8); *(LAS v4u*)(qimg + j * 1024 + ((c ^ (rr & 15)) << 4)) = v; } }
    const bf16* ksrc[2]; const bf16* vsrc[2];
#pragma unroll
    for (int i = 0; i < 2; ++i) { const int irow = 4 * (2 * wid + i) + (ln >> 4), cs = ln & 15, kv = (irow & 0x30) | swap23(irow & 15);
        ksrc[i] = KD + ((size_t)b * SEQ + kv) * 1024 + h * 128 + ((cs ^ (irow & 15)) << 3);
        const int d = 8 * (2 * wid + i) + (ln >> 3), vs = ln & 7;
        vsrc[i] = VDT + (size_t)(h * 128 + d) * MTOK + (size_t)b * SEQ + ((vs ^ ((d >> 1) & 7)) << 3); }
    const unsigned kdst = lds0 + DF_K0 + 2048 * wid, vdst = lds0 + DF_V0 + 2048 * wid;
#define DF_DMA(t_, buf_) do { _Pragma("unroll") for (int i_ = 0; i_ < 2; ++i_) { \
        glds16(ksrc[i_] + (size_t)(t_) * 64 * 1024, (unsigned)__builtin_amdgcn_readfirstlane(kdst + (buf_) * DF_KBUF + 1024 * i_)); \
        glds16(vsrc[i_] + (t_) * 64, (unsigned)__builtin_amdgcn_readfirstlane(vdst + (buf_) * DF_VBUF + 1024 * i_)); } } while (0)
    f32x16 O1[4], O2[4];
#pragma unroll
    for (int d = 0; d < 4; ++d) { O1[d] = f32x16{}; O2[d] = f32x16{}; }
    float m1 = -1e30f, l1 = 0.f, m2 = -1e30f, l2 = 0.f;
    DF_DMA(0, 0);
    asm volatile("s_waitcnt vmcnt(0)" ::: "memory");
    __syncthreads();
    const int xr = r & 15, vx = (r >> 1) & 7;
    const LAS unsigned char* qimg = F.lds + DF_Q0 + wid * 8192 + r * 256;
    for (int t = 0; t < ntiles; ++t) {
        const int cur = t & 1; const bool more = (t + 1 < ntiles);
        if (more) DF_DMA(t + 1, cur ^ 1);
        if (t <= my_last) {
            const LAS unsigned char* kb = F.lds + DF_K0 + cur * DF_KBUF + r * 256;
            const LAS unsigned char* vb = F.lds + DF_V0 + cur * DF_VBUF + r * 128;
            const bool band = t >= band_first;
            df_block(kb, qimg, hi, xr, vb, hi, vx, band, qpos, t * 64, hi, btab, m1, l1, O1);
            df_block(kb + 32 * 256, qimg, hi, xr, vb, 4 + hi, vx, band, qpos, t * 64 + 32, hi, btab, m1, l1, O1);
            df_block(kb, qimg, 8 + hi, xr, vb, hi, vx, band, qpos, t * 64, hi, btab, m2, l2, O2);
            df_block(kb + 32 * 256, qimg, 8 + hi, xr, vb, 4 + hi, vx, band, qpos, t * 64 + 32, hi, btab, m2, l2, O2);
        }
        asm volatile("s_waitcnt vmcnt(0)" ::: "memory");
        __syncthreads();
    }
#undef DF_DMA
    l1 += __shfl_xor(l1, 32); l2 += __shfl_xor(l2, 32);
    const float lam = *(const LAS float*)(F.lds + P2_LAM), c1 = 1.0f / l1, c2 = lam / l2;
    int ln2 = lane; asm volatile("" : "+v"(ln2)); const int hi2 = ln2 >> 5; const size_t row2 = (size_t)b * SEQ + qw + (ln2 & 31);
    float ss = 0.f;
#pragma unroll
    for (int d = 0; d < 4; ++d)
#pragma unroll
        for (int e = 0; e < 16; ++e) { const float a = O1[d][e] * c1 - O2[d][e] * c2; O1[d][e] = a; ss += a * a; }
    ss += __shfl_xor(ss, 32);
#ifdef ABL_QB
    const float rs = (qb == ABL_QB - 1) ? 0.f : __builtin_amdgcn_rsqf(ss * (1.0f / 128.0f) + LN_EPS) * (1.0f - LAM_INIT);
#else
    const float rs = __builtin_amdgcn_rsqf(ss * (1.0f / 128.0f) + LN_EPS) * (1.0f - LAM_INIT);
#endif
    const LAS float* sg = (const LAS float*)(F.lds + P2_SG);
#pragma unroll
    for (int d = 0; d < 4; ++d)
#pragma unroll
        for (int g = 0; g < 4; ++g) { const int dd = d * 32 + 8 * g + 4 * hi2;
            v2u w; w.x = pk2(O1[d][4 * g] * rs * sg[dd], O1[d][4 * g + 1] * rs * sg[dd + 1]); w.y = pk2(O1[d][4 * g + 2] * rs * sg[dd + 2], O1[d][4 * g + 3] * rs * sg[dd + 3]);
            *(GAS v2u*)(HB + row2 * 1024 + h * 128 + dd) = w; }
}
__device__ __forceinline__ void mem_unit(Frame& F, int b, int hm, int qb) {
    const int lane = F.lane, r = lane & 31, hi = lane >> 5, wid = F.wave;
    const bf16* QM = act(F, 5); bf16* HC = act(F, 6);
    const bf16* KM = (const bf16*)(F.dout + DO_KM); const bf16* VMT = (const bf16*)(F.dout + DO_VMT);
    const size_t row = (size_t)b * SEQ + qb * 256 + wid * 32 + r;
    const bf16* qrow = QM + row * 1024 + hm * 256 + hi * 8;
    const bf16* Kb = KM + (size_t)b * MEML * 1024 + hm * 256;
#pragma unroll 1
    for (int half = 0; half < 2; ++half) {
        const bf16* Vb = VMT + (size_t)(hm * 256 + half * 128) * MMEM + (size_t)b * MEML;
        f32x16 O[4]; float l;
        attn_pass<16, false, false>(F.lds, qrow, Kb, 1024, Vb, MMEM, 4, 3, 4, 0, O, l);
        const float inv = 1.0f / l;
#pragma unroll
        for (int d = 0; d < 4; ++d)
#pragma unroll
            for (int g = 0; g < 4; ++g) { const int dd = d * 32 + 8 * g + 4 * hi;
                v2u w; w.x = pk2(O[d][4 * g] * inv, O[d][4 * g + 1] * inv); w.y = pk2(O[d][4 * g + 2] * inv, O[d][4 * g + 3] * inv);
                *(GAS v2u*)(HC + row * 1024 + hm * 256 + half * 128 + dd) = w; }
    }
}
constexpr int SG_VNT = 0, SG_W = 34816, SG_ST = 69632, SG_ROWB = 272;
__device__ __forceinline__ void sgu_unit(Frame& F, const Args& A, int b, int chunk, int dry) {
    const int tid = F.tid, lane = F.lane, r = lane & 31, hi = lane >> 5, wid = F.wave;
    bf16* U = act(F, 0); const bf16* V = act(F, 1); bf16* HAo = dry ? act(F, 6) : act(F, 0);
    const size_t t0 = (size_t)b * SEQ + chunk * 128;
    const float *lng = A.in[3], *lnb = A.in[4], *wsp = A.in[5], *bsp = A.in[6];
    LAS float* st = (LAS float*)(F.lds + SG_ST);
#pragma unroll 1
    for (int i = 0; i < 16; ++i) { const int s = wid * 16 + i; const bf16* vr = V + (t0 + s) * 1024;
        const v4u a = *(const GAS v4u*)(vr + lane * 8), c = *(const GAS v4u*)(vr + 512 + lane * 8);
        float x[16] = {bflo(a.x), bfhi(a.x), bflo(a.y), bfhi(a.y), bflo(a.z), bfhi(a.z), bflo(a.w), bfhi(a.w), bflo(c.x), bfhi(c.x), bflo(c.y), bfhi(c.y), bflo(c.z), bfhi(c.z), bflo(c.w), bfhi(c.w)};
        float sm = 0.f;
#pragma unroll
        for (int j = 0; j < 16; ++j) sm += x[j];
        const float mean = wave_sum(sm) * (1.0f / 1024.0f); float sq = 0.f;
#pragma unroll
        for (int j = 0; j < 16; ++j) { const float d = x[j] - mean; sq += d * d; }
        const float rstd = __builtin_amdgcn_rsqf(wave_sum(sq) * (1.0f / 1024.0f) + LN_EPS);
        if (lane == 0) { st[2 * s] = mean; st[2 * s + 1] = rstd; } }
    __syncthreads();
#pragma unroll 1
    for (int g = 0; g < 8; ++g) {
#pragma unroll
        for (int i = 0; i < 4; ++i) { const int c = tid + 512 * i, s = c >> 4, part = c & 15; const int ch = g * 128 + part * 8;
            const v4u a = *(const GAS v4u*)(V + (t0 + s) * 1024 + ch); const float mean = st[2 * s], rstd = st[2 * s + 1];
            const f32x4 g0 = *(const GAS f32x4*)(lng + ch), g1 = *(const GAS f32x4*)(lng + ch + 4), b0 = *(const GAS f32x4*)(lnb + ch), b1 = *(const GAS f32x4*)(lnb + ch + 4);
            const float x[8] = {bflo(a.x), bfhi(a.x), bflo(a.y), bfhi(a.y), bflo(a.z), bfhi(a.z), bflo(a.w), bfhi(a.w)};
            const float gg[8] = {g0.x, g0.y, g0.z, g0.w, g1.x, g1.y, g1.z, g1.w}, bb[8] = {b0.x, b0.y, b0.z, b0.w, b1.x, b1.y, b1.z, b1.w};
#pragma unroll
            for (int e = 0; e < 8; ++e) *(LAS unsigned short*)(F.lds + SG_VNT + (part * 8 + e) * SG_ROWB + s * 2) = (unsigned short)f2bf((x[e] - mean) * rstd * gg[e] + bb[e]); }
#pragma unroll
        for (int i = 0; i < 8; ++i) { const int c = tid + 512 * i, t = c >> 5, part = c & 31, s0 = part * 4;
            const f32x4 w = *(const GAS f32x4*)(wsp + ((size_t)g * 128 + t) * 128 + s0);
            v2u o; o.x = pk2(s0 <= t ? w.x : 0.f, s0 + 1 <= t ? w.y : 0.f); o.y = pk2(s0 + 2 <= t ? w.z : 0.f, s0 + 3 <= t ? w.w : 0.f);
            *(LAS v2u*)(F.lds + SG_W + t * SG_ROWB + part * 8) = o; }
        __syncthreads();
        const int dblk = wid >> 1;
        f32x16 acc[2] = {f32x16{}, f32x16{}};
#pragma unroll
        for (int j = 0; j < 2; ++j) { const int tblk = 2 * (wid & 1) + j;
#pragma unroll
#ifdef ABL_NOSKIP
            for (int ks = 0; ks < 8; ++ks) {
#else
            for (int ks = 0; ks < 8; ++ks) if (ks <= 2 * tblk + 1) {
#endif
                const bf16x8 a = *(const LAS bf16x8*)(F.lds + SG_VNT + (dblk * 32 + r) * SG_ROWB + ks * 32 + hi * 16);
                const bf16x8 bq = *(const LAS bf16x8*)(F.lds + SG_W + (tblk * 32 + r) * SG_ROWB + ks * 32 + hi * 16);
                acc[j] = MFMA32(a, bq, acc[j]); } }
#pragma unroll
        for (int j = 0; j < 2; ++j) { const int t = (2 * (wid & 1) + j) * 32 + r; const float bs = bsp[g * 128 + t] * BIASSC; bf16* up = U + (t0 + t) * 1024 + g * 128 + dblk * 32 + 4 * hi;
#pragma unroll
            for (int q = 0; q < 4; ++q) { const v2u uu = *(const GAS v2u*)(up + 8 * q);
                v2u o; o.x = pk2(bflo(uu.x) * (acc[j][4 * q] * MIXSC + bs), bfhi(uu.x) * (acc[j][4 * q + 1] * MIXSC + bs)); o.y = pk2(bflo(uu.y) * (acc[j][4 * q + 2] * MIXSC + bs), bfhi(uu.y) * (acc[j][4 * q + 3] * MIXSC + bs));
                *(GAS v2u*)(HAo + (up - U) + 8 * q) = o; } }
        __syncthreads();
    }
}
__device__ __forceinline__ int t5_bucket(int n) {
    if (n < 16) return n;
    int l = 16 + (int)(logf((float)n / 16.0f) / 2.0794415416798357f * 16.0f);
    return l < 31 ? l : 31;
}
__device__ __forceinline__ void p2_phase(Frame& F, const Args& A, int dry) {
    {
        LAS float* bt = (LAS float*)(F.lds + P2_BT); LAS float* sg = (LAS float*)(F.lds + P2_SG); LAS float* lm = (LAS float*)(F.lds + P2_LAM);
        if (F.tid < 128) sg[F.tid] = A.in[11][F.tid];
        if (F.wave == 2) { const float a = wave_sum(A.in[7][F.lane] * A.in[8][F.lane]), c = wave_sum(A.in[9][F.lane] * A.in[10][F.lane]); if (F.lane == 0) lm[0] = expf(a) - expf(c) + LAM_INIT; }
    }
    __syncthreads();
    for (int v = F.vcu; v < 256; v += F.G) {
        const int x = v >> 5, w = v & 31;
#pragma unroll 1
        for (int rd = 0; rd < 4; ++rd) {
            const int bh = 16 * x + 4 * rd + (w >> 3), qb = (rd & 1) ? 7 - (w & 7) : (w & 7), b = bh >> 3, h = bh & 7;
            { LAS float* bt = (LAS float*)(F.lds + P2_BT); const float* tab = A.in[12];
              if (F.tid < 128) bt[F.tid] = (tab[t5_bucket(F.tid) * 8 + h] - tab[31 * 8 + h]) * LOG2E; }
            __syncthreads();
            if (!dry || (DRYMASK & 1)) diff_unit(F, b, h, qb, dry);
        }
    }
    for (int v = F.vcu; v < 256; v += F.G) {
#pragma unroll 1
        for (int i = 0; i < 2; ++i) { const int id = 2 * v + i;
#ifndef ONLY_DIFF
            if (!dry || (DRYMASK & 2)) mem_unit(F, id >> 5, (id >> 3) & 3, id & 7);
#endif
        }
    }
#ifndef ONLY_DIFF
    if (!dry || (DRYMASK & 4)) for (int v = F.vcu; v < 256; v += F.G) sgu_unit(F, A, v >> 4, v & 15, dry);
#endif
}

__device__ __forceinline__ void ln1_rows(Frame& F, const Args& A) {
    const int gw = F.vcu * NWAVES + F.wave, NGW = F.G * NWAVES;
    float* R = (float*)F.dout; bf16* X1B = act(F, 0); const float *g = A.in[18], *bb = A.in[19];
    f32x4 gv[4], bv[4];
#pragma unroll
    for (int j = 0; j < 4; ++j) { gv[j] = *(const GAS f32x4*)(g + 4 * F.lane + 256 * j); bv[j] = *(const GAS f32x4*)(bb + 4 * F.lane + 256 * j); }
    for (int m = gw; m < MTOK; m += NGW) {
        GAS f32x4* xr = (GAS f32x4*)(R + (size_t)m * 1024) + F.lane;
        f32x4 v[4]; float s = 0.f;
#pragma unroll
        for (int j = 0; j < 4; ++j) { v[j] = xr[64 * j]; s += (v[j].x + v[j].y) + (v[j].z + v[j].w); }
        const float mean = wave_sum(s) * (1.f / 1024.f); float s2 = 0.f;
#pragma unroll
        for (int j = 0; j < 4; ++j) { v[j] = v[j] - mean; s2 += (v[j].x * v[j].x + v[j].y * v[j].y) + (v[j].z * v[j].z + v[j].w * v[j].w); }
        const float rstd = __builtin_amdgcn_rsqf(wave_sum(s2) * (1.f / 1024.f) + LN_EPS);
        GAS v2u* o8 = (GAS v2u*)(X1B + (size_t)m * 1024) + F.lane;
#pragma unroll
        for (int j = 0; j < 4; ++j) { const f32x4 y = v[j] * rstd * gv[j] + bv[j]; xr[64 * j] = y; v2u w; w.x = pk2(y.x, y.y); w.y = pk2(y.z, y.w); o8[64 * j] = w; }
    }
}

constexpr int TK_ROWB = 528;
#define MED3(a, b, c) __builtin_amdgcn_fmed3f((a), (b), (c))
__device__ __forceinline__ void topk_phase(Frame& F) {
    const int lane = F.lane, p = lane & 31, half = lane >> 5;
    const int gw = F.vcu * NWAVES + F.wave, NGW = F.G * NWAVES;
    LAS unsigned char* tile = F.lds + RING_OFF + F.wave * (32 * TK_ROWB);
    int* IDX = (int*)(F.ws + WS_A0 + 3 * ACT_BYTES); float* GATE = (float*)(F.ws + WS_A0 + 3 * ACT_BYTES + 16 * MiB);
    for (int it = gw; it < (MTOK / 32) * 8; it += NGW) {
        const int h = it & 7, t0 = (it >> 3) * 32;
        const bf16* S = act(F, h < 4 ? 2 : 5) + (size_t)t0 * 1024 + (h & 3) * 256;
#pragma unroll
        for (int i = 0; i < 16; ++i) { const int row = 2 * i + half; const v4u v = *(const GAS v4u*)(S + (size_t)row * 1024 + p * 8); *(LAS v4u*)(tile + row * TK_ROWB + p * 16) = v; }
        LDS_WAIT(); asm volatile("" ::: "memory");
        float L[16];
#pragma unroll
        for (int i = 0; i < 16; ++i) L[i] = -INFINITY;
        const LAS unsigned char* myrow = tile + p * TK_ROWB + half * 256;
#pragma unroll 2
        for (int j = 0; j < 16; ++j) {
            const v4u w = *(const LAS v4u*)(myrow + j * 16);
            const unsigned ww[4] = {w.x, w.y, w.z, w.w};
#pragma unroll
            for (int e = 0; e < 8; ++e) {
                const unsigned bits = ((e & 1) ? (ww[e >> 1] & 0xffff0000u) : (ww[e >> 1] << 16)) | (unsigned)(j * 8 + e);
                const float v = __uint_as_float(bits);
#pragma unroll
                for (int i = 15; i >= 1; --i) L[i] = MED3(L[i - 1], L[i], v);
                L[0] = fmaxf(L[0], v);
            }
        }
        float A[16], Bv[16];
#pragma unroll
        for (int i = 0; i < 16; ++i) { const float o = __shfl_xor(L[i], 32); A[i] = half ? o : L[i]; Bv[i] = half ? L[i] : o; }
        LAS unsigned* mine = (LAS unsigned*)(tile + p * TK_ROWB + half * 256);
        asm volatile("" ::: "memory");
#pragma unroll
        for (int i = 0; i < 16; ++i) { mine[i] = __float_as_uint(A[i]) & 0x7fu; mine[16 + i] = __float_as_uint(Bv[i]) & 0x7fu; }
        float T[16];
#pragma unroll
        for (int i = 0; i < 16; ++i) T[i] = -INFINITY;
#pragma unroll
        for (int i = 0; i < 16; ++i)
#pragma unroll
            for (int j = 0; j < 16; ++j) if ((i + 1) * (j + 1) <= 16) {
                const float sum = __uint_as_float(__float_as_uint(A[i]) & 0xffff0000u) + __uint_as_float(__float_as_uint(Bv[j]) & 0xffff0000u);
                const float v = __uint_as_float((__float_as_uint(sum) & 0xffffff00u) | (unsigned)(i * 16 + j));
#pragma unroll
                for (int q = 15; q >= 1; --q) T[q] = MED3(T[q - 1], T[q], v);
                T[0] = fmaxf(T[0], v);
            }
        float e[16], den = 0.f; const float mxs = __uint_as_float(__float_as_uint(T[0]) & 0xffffff00u);
#pragma unroll
        for (int q = 0; q < 16; ++q) { e[q] = __expf(__uint_as_float(__float_as_uint(T[q]) & 0xffffff00u) - mxs); den += e[q]; }
        const float inv = 1.0f / den;
        LDS_WAIT(); asm volatile("" ::: "memory");
        int id8[8]; float g8[8];
#pragma unroll
        for (int q = 0; q < 8; ++q) {
            const float tv = half ? T[8 + q] : T[q]; const unsigned code = __float_as_uint(tv) & 0xffu;
            id8[q] = (int)(mine[code >> 4] * 128u + mine[16 + (code & 15u)]); g8[q] = (half ? e[8 + q] : e[q]) * inv;
        }
        const size_t o = (size_t)(t0 + p) * 128 + h * 16 + half * 8;
        *(GAS v4u*)(IDX + o) = (v4u){(unsigned)id8[0], (unsigned)id8[1], (unsigned)id8[2], (unsigned)id8[3]}; *(GAS v4u*)(IDX + o + 4) = (v4u){(unsigned)id8[4], (unsigned)id8[5], (unsigned)id8[6], (unsigned)id8[7]};
        *(GAS f32x4*)(GATE + o) = (f32x4){g8[0], g8[1], g8[2], g8[3]}; *(GAS f32x4*)(GATE + o + 4) = (f32x4){g8[4], g8[5], g8[6], g8[7]};
        LDS_WAIT(); asm volatile("" ::: "memory");
    }
}

__device__ __forceinline__ void fp8x16_to_f32(const v4u& a, float (&f)[16]) {
#pragma unroll
    for (int j = 0; j < 4; ++j) { const f32x2_t lo = __builtin_amdgcn_cvt_pk_f32_fp8((int)a[j], false), hi = __builtin_amdgcn_cvt_pk_f32_fp8((int)a[j], true);
        f[4 * j] = lo.x; f[4 * j + 1] = lo.y; f[4 * j + 2] = hi.x; f[4 * j + 3] = hi.y; }
}
__device__ __forceinline__ void peer_phase(Frame& F, const Args& A, int dry) {
    const int lane = F.lane;
    const int gw = F.vcu * NWAVES + F.wave, NGW = F.G * NWAVES;
    const int* IDX = (const int*)(F.ws + WS_A0 + 3 * ACT_BYTES); const float* GATE = (const float*)(F.ws + WS_A0 + 3 * ACT_BYTES + 16 * MiB);
    const unsigned char* PU4 = (const unsigned char*)act(F, 1); const unsigned char* PV8 = PU4 + 16 * MiB; const float* PUS = (const float*)(PU4 + 32 * MiB); const float* PVS = PUS + NEXP;
    float* X1 = (float*)F.dout; const float *g2 = A.in[24], *b2 = A.in[25];
    for (int m = gw; m < MTOK; m += NGW) {
        const int id0 = IDX[(size_t)m * 128 + lane], id1 = IDX[(size_t)m * 128 + 64 + lane];
        const float ga0 = GATE[(size_t)m * 128 + lane], ga1 = GATE[(size_t)m * 128 + 64 + lane];
        const float su0 = PUS[id0], su1 = PUS[id1], sv0 = PVS[id0], sv1 = PVS[id1];
        float* xr = X1 + (size_t)m * 1024 + 16 * lane;
        float x[16];
#pragma unroll
        for (int j = 0; j < 4; ++j) { const f32x4 t = *(const GAS f32x4*)(xr + 4 * j); x[4 * j] = t.x; x[4 * j + 1] = t.y; x[4 * j + 2] = t.z; x[4 * j + 3] = t.w; }
#define PEER_LOADG(buf, tab, idv, l0) do { _Pragma("unroll") for (int e_ = 0; e_ < 8; ++e_) { const int row_ = __builtin_amdgcn_readlane((idv), (l0) + e_); buf[e_] = *(const GAS v4u*)((tab) + (size_t)row_ * 1024 + 16 * lane); } } while (0)
#define PEER_LOADU(buf, idv, l0) do { _Pragma("unroll") for (int e_ = 0; e_ < 8; ++e_) { const int row_ = __builtin_amdgcn_readlane((idv), (l0) + e_); buf[e_] = *(const GAS v2u*)(PU4 + (size_t)row_ * 512 + 8 * lane); } } while (0)
#define PEER_DOTG(buf, o0) do { _Pragma("unroll") for (int e_ = 0; e_ < 8; ++e_) { \
            const unsigned h_ = __builtin_amdgcn_udot8(xh1, buf[e_].y, __builtin_amdgcn_udot8(xh0, buf[e_].x, 0u, false), false), l_ = __builtin_amdgcn_udot8(xl1, buf[e_].y, __builtin_amdgcn_udot8(xl0, buf[e_].x, 0u, false), false); \
            pr[(o0) + e_] = (float)(16u * h_ + l_); } __builtin_amdgcn_sched_barrier(0); } while (0)
#define PEER_AXPYG(buf, wv_, l0) do { _Pragma("unroll") for (int e_ = 0; e_ < 8; ++e_) { const float w_ = __builtin_bit_cast(float, __builtin_amdgcn_readlane(__builtin_bit_cast(int, (wv_)), (l0) + e_)); \
            float f_[16]; fp8x16_to_f32(buf[e_], f_); _Pragma("unroll") for (int j_ = 0; j_ < 16; ++j_) y[j_] += w_ * f_[j_]; } __builtin_amdgcn_sched_barrier(0); } while (0)
        v4u b0[8], b1[8]; v2u c0[8], c1[8];
        float d01 = 0.f, d23 = 0.f;
        float ax = 0.f;
#pragma unroll
        for (int j = 0; j < 16; ++j) ax = fmaxf(ax, fabsf(x[j]));
#pragma unroll
        for (int o = 1; o < 64; o <<= 1) ax = fmaxf(ax, __shfl_xor(ax, o));
        const float dx = fmaxf(ax, 1e-30f) * (1.0f / 127.0f), idx_ = 1.0f / dx;
        unsigned xh0 = 0u, xh1 = 0u, xl0 = 0u, xl1 = 0u; int sxi = 0;
#pragma unroll
        for (int j = 0; j < 16; ++j) { int X = (int)rintf(x[j] * idx_) + 128; X = X < 0 ? 0 : (X > 255 ? 255 : X); sxi += X;
            if (j < 8) { xh0 |= (unsigned)(X >> 4) << (4 * j); xl0 |= (unsigned)(X & 15) << (4 * j); } else { xh1 |= (unsigned)(X >> 4) << (4 * (j - 8)); xl1 |= (unsigned)(X & 15) << (4 * (j - 8)); } }
        const float sxt = wave_sum((float)sxi) * 7.5f - 128.0f * 7.5f * 1024.0f;
        const float uq0 = PUS[2 * NEXP + id0] * 128.0f, uq1 = PUS[2 * NEXP + id1] * 128.0f;
        PEER_LOADU(c0, id0, 0);
#pragma unroll 1
        for (int blk = 0; blk < 4; ++blk) {
            const int idv = blk < 2 ? id0 : id1, l0 = (blk & 1) * 32;
            float pr[32];
            PEER_LOADU(c1, idv, l0 + 8);  __builtin_amdgcn_sched_barrier(0);
            PEER_DOTG(c0, 0);
            PEER_LOADU(c0, idv, l0 + 16); __builtin_amdgcn_sched_barrier(0);
            PEER_DOTG(c1, 8);
            PEER_LOADU(c1, idv, l0 + 24); __builtin_amdgcn_sched_barrier(0);
            PEER_DOTG(c0, 16);
            if (blk < 3) { const int idn = blk < 1 ? id0 : id1, ln = ((blk + 1) & 1) * 32; PEER_LOADU(c0, idn, ln); }
            else PEER_LOADG(b0, PV8, id0, 0);
            __builtin_amdgcn_sched_barrier(0);
            PEER_DOTG(c1, 24);
#pragma unroll
            for (int s = 16; s >= 1; s >>= 1) {
                const bool up = (lane & s) != 0;
#pragma unroll
                for (int i = 0; i < s; ++i) { const float lo = pr[i], hv = pr[i + s]; const float send = up ? lo : hv, keep = up ? hv : lo; pr[i] = keep + __shfl_xor(send, s); }
            }
            const float d = pr[0] + __shfl_xor(pr[0], 32) - sxt; const bool mine = (lane >> 5) == (blk & 1);
            if (blk < 2) d01 = mine ? d : d01; else d23 = mine ? d : d23;
        }
        const float wg0 = ga0 * gelu1((d01 - uq0) * (su0 * dx)) * sv0;
        const float wg1 = ga1 * gelu1((d23 - uq1) * (su1 * dx)) * sv1;
        float y[16];
#pragma unroll
        for (int j = 0; j < 16; ++j) y[j] = 0.f;
#pragma unroll 1
        for (int gg = 0; gg < 8; ++gg) {
            const int ida = gg < 4 ? id0 : id1; const float wa = gg < 4 ? wg0 : wg1; const int la = (gg & 3) * 16;
            PEER_LOADG(b1, PV8, ida, la + 8); __builtin_amdgcn_sched_barrier(0);
            PEER_AXPYG(b0, wa, la);
            if (gg < 7) { const int idb = gg < 3 ? id0 : id1, lb = ((gg + 1) & 3) * 16; PEER_LOADG(b0, PV8, idb, lb); }
            __builtin_amdgcn_sched_barrier(0);
            PEER_AXPYG(b1, wa, la + 8);
        }
#undef PEER_LOADG
#undef PEER_LOADU
#undef PEER_DOTG
#undef PEER_AXPYG
        f32x4 v[4]; float s = 0.f;
#pragma unroll
        for (int j = 0; j < 4; ++j) { v[j] = (f32x4){x[4 * j], x[4 * j + 1], x[4 * j + 2], x[4 * j + 3]} * ALPHA + (f32x4){y[4 * j], y[4 * j + 1], y[4 * j + 2], y[4 * j + 3]} * (ABL_PEER == 1 ? 0.f : ABL_PEER == 2 ? 0.5f : ABL_PEER == 3 ? 2.f : 1.f); s += (v[j].x + v[j].y) + (v[j].z + v[j].w); }
        const float mean = wave_sum(s) * (1.f / 1024.f); float s2 = 0.f;
#pragma unroll
        for (int j = 0; j < 4; ++j) { v[j] = v[j] - mean; s2 += (v[j].x * v[j].x + v[j].y * v[j].y) + (v[j].z * v[j].z + v[j].w * v[j].w); }
        const float rstd = __builtin_amdgcn_rsqf(wave_sum(s2) * (1.f / 1024.f) + LN_EPS);
        float* orow = (dry ? (float*)act(F, 5) + (size_t)m * 1024 : X1 + (size_t)m * 1024) + 16 * lane;
#pragma unroll
        for (int j = 0; j < 4; ++j) { const f32x4 gg = *(const GAS f32x4*)(g2 + 16 * lane + 4 * j), bb = *(const GAS f32x4*)(b2 + 16 * lane + 4 * j);
            *(GAS f32x4*)(orow + 4 * j) = v[j] * rstd * gg + bb; }
    }
}

__global__ void __launch_bounds__(NWAVES * 64, 2) mk_fwd(Args A) {
    extern __shared__ __attribute__((aligned(16))) unsigned char lds[];
    Frame F;
    F.lds = (LAS unsigned char*)lds;
    F.MISC = (volatile LAS unsigned*)(F.lds + MISC_OFF);
    F.tid = threadIdx.x; F.lane = F.tid & 63; F.wave = __builtin_amdgcn_readfirstlane(F.tid >> 6);
    F.G = gridDim.x; { const int bx = blockIdx.x; F.vcu = (F.G % 8 == 0) ? (bx % 8) * (F.G / 8) + bx / 8 : bx; }
    F.ws = A.ws; F.dout = (unsigned char*)A.out; F.ctl = (gu32*)(A.ws + WS_CTL);
    for (int u = F.tid; u < (LDS_BYTES - LDSCTL_OFF) / 4; u += NWAVES * 64) ((LAS unsigned*)(F.lds + LDSCTL_OFF))[u] = 0u;
    __syncthreads();
    XcdBarrier bar; bar.bar = (unsigned*)(F.ctl + CW_BAR); bar.x = 0; bar.st = nullptr;
    if (N_LAUNCHES != PER_PHASE) bar = xcd_barrier_post((unsigned*)(F.ctl + CW_BAR), F.MISC + 8);
#define GRID_BAR() do { if (N_LAUNCHES != PER_PHASE) xcd_barrier(bar); } while (0)
#ifdef TSTAMP
    unsigned long long* tsb = (unsigned long long*)(A.ws + 131072); int nst = 0;
#define STAMP() do { if (blockIdx.x == 0 && F.tid == 0) tsb[nst] = __builtin_amdgcn_s_memrealtime(); ++nst; } while (0)
    STAMP();
#else
#define STAMP() do {} while (0)
#endif
#ifndef REPEAT_PH
#define REPEAT_PH -1
#endif

    const int lo = A.ph_lo, hi = A.ph_hi;
#ifndef MK_PHASE_MASK
#define MK_PHASE_MASK 0x3ff
#endif
#define IN(k) (((MK_PHASE_MASK >> (k)) & 1) && lo <= (k) && (k) < hi)
#define BOTH(k) (IN(k) && IN((k) + 1))
    const bf16* XB = (const bf16*)(F.dout + DO_XB);

    if (IN(0)) { p0_prologue(F, A); if (BOTH(0)) GRID_BAR(); STAMP(); }

    if (IN(1)) {
        { pg8::Gemm g{XB, wsb(F, WS_WVDT), (const bf16*)(F.dout + DO_MEMB), wsb(F, WS_WMVT), wsb(F, WS_W1T), XB, wsb(F, WS_WMKT), (const bf16*)(F.dout + DO_MEMB), 1024};
          pg8::MultiOrder S; S.init(F.G, (int)blockIdx.x, 128, 20, 4, 128, 16, 4, 4, 16);
          pg8::EpiP1 E{act(F, 0), act(F, 1), act(F, 2), act(F, 3), act(F, 5), act(F, 4), (bf16*)(F.dout + DO_KM), (bf16*)(F.dout + DO_VMT)};
          pg8::gemm_phase<pg8::EpiP1, pg8::MultiOrder, true, true>(F.lds + RING_OFF, g, S, E); }
        { pg8::Gemm g{wsb(F, WS_SKD), nullptr, nullptr, nullptr, wsb(F, WS_WPQ), nullptr, nullptr, nullptr, 2048};
          pg8::MultiOrder S; S.init(F.G, (int)blockIdx.x, 8, 4);
          pg8::EpiPlain E{wsb(F, WS_WST), 1024};
          pg8::gemm_phase<pg8::EpiPlain, pg8::MultiOrder, true, true>(F.lds + RING_OFF, g, S, E); }
        if (BOTH(1)) GRID_BAR(); STAMP();
    }

    if (IN(2)) { p2_phase(F, A, A.pad); if (BOTH(2)) GRID_BAR(); STAMP(); }

    if (IN(3)) {
        pg8::Gemm g{XB, nullptr, nullptr, nullptr, wsb(F, WS_WGT), nullptr, nullptr, nullptr, 1024};
        pg8::MultiOrder S; S.init(F.G, (int)blockIdx.x, 128, 12);
#ifdef SWAPG
        pg8::EpiSplit<3> E{act(F, 3), act(F, 1), act(F, 4), A.in[15]};
#else
        pg8::EpiSplit<3> E{act(F, 1), act(F, 3), act(F, 4), A.in[15]};
#endif
        pg8::gemm_phase<pg8::EpiSplit<3>, pg8::MultiOrder, true, true>(F.lds + RING_OFF, g, S, E);
        if (BOTH(3)) GRID_BAR(); STAMP();
    }

    if (IN(4)) {
        pg8::Gemm g{act(F, 0), act(F, 2), act(F, 6), nullptr, wsb(F, WS_WBT), wsb(F, WS_WBT) + (size_t)1024 * 1024, wsb(F, WS_WBT) + (size_t)2 * 1024 * 1024, nullptr, 1024};
        pg8::MultiOrder S; S.init(F.G, (int)blockIdx.x, 128, 4, 128, 4, 128, 4);
        pg8::EpiMerge E{act(F, 5), act(F, 1), act(F, 3), act(F, 4)};
        pg8::gemm_phase<pg8::EpiMerge, pg8::MultiOrder, true, true>(F.lds + RING_OFF, g, S, E);
        if (BOTH(4)) GRID_BAR(); STAMP();
    }

    if (IN(5)) {
        pg8::Gemm g{act(F, 5), nullptr, nullptr, nullptr, wsb(F, WS_WOT), nullptr, nullptr, nullptr, 1024};
        pg8::MultiOrder S; S.init(F.G, (int)blockIdx.x, 128, 4);
        pg8::EpiResid E{A.in[0], (float*)F.dout, ALPHA};
        pg8::gemm_phase<pg8::EpiResid, pg8::MultiOrder, true, true>(F.lds + RING_OFF, g, S, E);
        const int gw = F.vcu * NWAVES + F.wave, NGW = F.G * NWAVES;
        unsigned char* P8 = (unsigned char*)act(F, 1); float* PS = (float*)(P8 + 32 * MiB);
        for (int m = gw; m < 2 * NEXP; m += NGW) {
            if (m < NEXP) cvt_row_int4(A.in[22] + (size_t)m * 1024, P8 + (size_t)m * 512, PS + m, PS + 2 * NEXP + m, F.lane);
            else cvt_row_fp8(A.in[23] + (size_t)(m - NEXP) * 1024, P8 + (size_t)m * 1024, PS + m, F.lane); }
        if (BOTH(5)) GRID_BAR(); STAMP();
    }

    if (IN(6)) { ln1_rows(F, A); if (BOTH(6)) GRID_BAR(); STAMP(); }

    if (IN(7)) {
        pg8::Gemm g{act(F, 0), nullptr, nullptr, nullptr, wsb(F, WS_WST), nullptr, nullptr, nullptr, 1024};
        pg8::MultiOrder S; S.init(F.G, (int)blockIdx.x, 128, 8);
        pg8::EpiSplit<0> E{act(F, 2), act(F, 5), act(F, 5), A.in[15]};
        pg8::gemm_phase<pg8::EpiSplit<0>, pg8::MultiOrder, true, true>(F.lds + RING_OFF, g, S, E);
        if (BOTH(7)) GRID_BAR(); STAMP();
    }

    if (IN(8)) { topk_phase(F); if (BOTH(8)) GRID_BAR(); STAMP(); }

    if (IN(9)) { peer_phase(F, A, A.pad); STAMP(); }
#undef IN
#undef BOTH
}


#ifdef TSTAMP
__global__ void __launch_bounds__(256) ts_encode(float* out, const unsigned long long* ts, int k) {
    const float us = (float)(ts[k + 1] - ts[k]) * 0.01f; const float C = sqrtf(us);
    for (size_t i = (size_t)blockIdx.x * blockDim.x + threadIdx.x; i < (size_t)MTOK * DM; i += (size_t)gridDim.x * blockDim.x) out[i] = C;
}
#endif
extern "C" void kernel_launch(void* const* d_in, const int* in_sizes, int n_in, void* d_out, int out_size, void* d_ws, size_t ws_size, hipStream_t stream) {
    static int grid = 0;
    if (grid == 0) {
        if (n_in != 26 || in_sizes[0] != MTOK * DM || out_size != MTOK * DM || ws_size < WS_END) {
            fprintf(stderr, "kernel_launch: unexpected shapes (n_in %d, in0 %d, out %d, ws %zu; need ws >= %zu); nothing launched\n", n_in, n_in > 0 ? in_sizes[0] : -1, out_size, ws_size, (size_t)WS_END); grid = -1; return; }
        int dev = 0, cus = 0, per_cu = 0;
        if (hipGetDevice(&dev) != hipSuccess || hipDeviceGetAttribute(&cus, hipDeviceAttributeMultiprocessorCount, dev) != hipSuccess) { fprintf(stderr, "kernel_launch: device query failed\n"); grid = -1; return; }
        if (hipFuncSetAttribute((const void*)mk_fwd, hipFuncAttributeMaxDynamicSharedMemorySize, LDS_BYTES) != hipSuccess) { fprintf(stderr, "kernel_launch: hipFuncSetAttribute failed\n"); grid = -1; return; }
        if (hipOccupancyMaxActiveBlocksPerMultiprocessor(&per_cu, (const void*)mk_fwd, NWAVES * 64, LDS_BYTES) != hipSuccess || per_cu < 1) { fprintf(stderr, "kernel_launch: occupancy query reports %d workgroups per CU\n", per_cu); }
        (void)hipGetLastError();
        grid = cus;
    }
    if (grid < 0) return;
    if (hipMemsetAsync((char*)d_ws + WS_CTL, 0, CTL_ZERO_BYTES, stream) != hipSuccess) { fprintf(stderr, "kernel_launch: hipMemsetAsync failed\n"); return; }
    Args a{};
    for (int i = 0; i < 26; ++i) a.in[i] = (const float*)d_in[i];
    a.out = (float*)d_out; a.ws = (unsigned char*)d_ws;
#ifdef ABL_TWICE
    for (int rep = 0; rep < 2; ++rep) {
    if (rep) (void)hipMemsetAsync((char*)d_ws + WS_CTL, 0, CTL_ZERO_BYTES, stream);
#endif
#ifdef DBG
    {
        constexpr int last_phase = DBG == 1 ? 1 : DBG <= 4 ? 2 : DBG == 5 ? 3 : DBG == 6 ? 4 : DBG == 7 ? 5 : DBG == 8 ? 6 : DBG == 9 ? 7 : DBG == 10 ? 8 : 9;
        for (int li = 0; li <= last_phase; ++li) { a.ph_lo = li; a.ph_hi = li + 1; a.li = li; hipLaunchKernelGGL(mk_fwd, dim3(grid), dim3(NWAVES * 64), LDS_BYTES, stream, a); }
        DbgP P{}; for (int i = 0; i < 26; ++i) P.in[i] = (const float*)d_in[i]; P.ws = (unsigned char*)d_ws; P.dout = (unsigned char*)d_out; P.st = (float*)((char*)d_ws + 65536);
        if (DBG == 1) hipLaunchKernelGGL(chk_p1, dim3(375), dim3(256), 0, stream, P);
        if (DBG == 2) hipLaunchKernelGGL(chk_sgu, dim3(512), dim3(128), 0, stream, P);
        if (DBG == 3) hipLaunchKernelGGL(chk_diff, dim3(600), dim3(256), 0, stream, P);
        if (DBG == 4) hipLaunchKernelGGL(chk_mem, dim3(400), dim3(256), 0, stream, P);
        if (DBG == 5 || DBG == 6 || DBG == 7 || DBG == 9) hipLaunchKernelGGL(chk_gemm, dim3(150), dim3(256), 0, stream, P, (int)DBG);
        if (DBG == 8) hipLaunchKernelGGL(chk_ln1, dim3(128), dim3(256), 0, stream, P);
        if (DBG == 10) hipLaunchKernelGGL(chk_topk, dim3(16), dim3(256), 0, stream, P);
        if (DBG == 11) hipLaunchKernelGGL(chk_final, dim3(300), dim3(256), 0, stream, P);
        hipLaunchKernelGGL(dbg_encode, dim3(2048), dim3(256), 0, stream, (float*)d_out, (const float*)P.st, (int)DBG_PAIR);
        return;
    }
#endif
    const int nl = (N_LAUNCHES == PER_PHASE) ? PER_PHASE : 1;
    for (int li = 0; li < nl; ++li) {
        a.ph_lo = (N_LAUNCHES == PER_PHASE) ? li : 0; a.ph_hi = (N_LAUNCHES == PER_PHASE) ? li + 1 : PER_PHASE; a.li = li;
        if (N_LAUNCHES == PER_PHASE && li == REPEAT_PH) { a.pad = 1; hipLaunchKernelGGL(mk_fwd, dim3(grid), dim3(NWAVES * 64), LDS_BYTES, stream, a); a.pad = 0; }
        hipLaunchKernelGGL(mk_fwd, dim3(grid), dim3(NWAVES * 64), LDS_BYTES, stream, a);
        const hipError_t le = hipPeekAtLastError();
        if (le != hipSuccess) { fprintf(stderr, "kernel_launch: launch %d failed: %s\n", li, hipGetErrorName(le)); break; }
    }
#ifdef TSTAMP
    hipLaunchKernelGGL(ts_encode, dim3(2048), dim3(256), 0, stream, (float*)d_out, (const unsigned long long*)((char*)d_ws + 131072), (int)TSTAMP);
#endif
#ifdef ABL_TWICE
    }
#endif
}
```
